# Optimizing an MI355X kernel written in HIP

```python
import math
import jax, jax.numpy as jnp
from jax import lax
import numpy as np

D_MODEL = 1024
BATCH = 8
SEQ = 2048
DEPTH = 1
DEC_BATCH = 128
DEC_SEQ = 1
PAST_LEN = 16384
PAGE_SIZE = 128

ML_HEADS = 4
ML_DK = D_MODEL // 8
ML_DV = D_MODEL // 8
ML_WIDTH = ML_HEADS * ML_DV
ML_QK_WIDTH = ML_HEADS * ML_DK
ML_CHUNK = 128
CM_HEADS = 4
CM_HEAD_DIM = D_MODEL // 8
CM_WIDTH = CM_HEADS * CM_HEAD_DIM
CM_CHUNK = 128
MIX_WIDTH = ML_WIDTH + CM_WIDTH
IN_SIZES = (ML_QK_WIDTH, ML_QK_WIDTH, ML_WIDTH, ML_WIDTH, ML_HEADS, ML_HEADS, CM_WIDTH, CM_WIDTH)
N_IN = sum(IN_SIZES)
D_FF = -(-8 * D_MODEL // (3 * 256)) * 256
N_MOD = 6
EPS = 1e-6

kernel_name = "hybrid_mlstm_chunkmlp_decode_step"


def rmsnorm(x, g):
    x32 = x.astype(jnp.float32)
    y = x32 * lax.rsqrt(jnp.mean(x32 * x32, axis=-1, keepdims=True) + EPS)
    return (y * g.astype(jnp.float32)).astype(x.dtype)


def layernorm(x, g, b):
    x32 = x.astype(jnp.float32)
    mu = jnp.mean(x32, axis=-1, keepdims=True)
    var = jnp.mean(jnp.square(x32 - mu), axis=-1, keepdims=True)
    y = (x32 - mu) * lax.rsqrt(var + EPS)
    return (y * g.astype(jnp.float32) + b.astype(jnp.float32)).astype(x.dtype)


def split_cols(a, sizes):
    idx = np.cumsum(sizes)[:-1].tolist()
    return jnp.split(a, idx, axis=-1)


def mlstm_chunkwise(q, k, v, i_pre, f_pre, C0, n0, m0):
    B, T, H, _ = q.shape
    L = math.gcd(T, ML_CHUNK)
    nc = T // L

    def to_chunks(a):
        a = a.reshape((B, nc, L) + a.shape[2:])
        a = jnp.moveaxis(a, 3, 2)
        return jnp.moveaxis(a, 1, 0)

    qc = to_chunks(q) * (ML_DK ** -0.5)
    kc = to_chunks(k)
    vc = to_chunks(v)
    ic = to_chunks(i_pre)
    lfc = jax.nn.log_sigmoid(to_chunks(f_pre))
    causal = jnp.tril(jnp.ones((L, L), dtype=bool))

    def step(carry, xs):
        C, n, m = carry
        qb, kb, vb, ib, lfb = xs
        b = jnp.cumsum(lfb, axis=-1)
        D = jnp.where(causal, b[..., :, None] - b[..., None, :] + ib[..., None, :], -jnp.inf)
        inter = b + m[..., None]
        m_t = jnp.maximum(inter, jnp.max(D, axis=-1))
        w_intra = jnp.exp(D - m_t[..., None])
        w_inter = jnp.exp(inter - m_t)
        s = jnp.einsum('bhtd,bhsd->bhts', qb, kb) * w_intra
        num = jnp.einsum('bhts,bhse->bhte', s, vb) + w_inter[..., None] * jnp.einsum('bhed,bhtd->bhte', C, qb)
        den = jnp.sum(s, axis=-1) + w_inter * jnp.einsum('bhd,bhtd->bht', n, qb)
        h = num / jnp.maximum(jnp.abs(den), jnp.exp(-m_t))[..., None]
        g = b[..., -1:] - b + ib
        dec = b[..., -1] + m
        m_new = jnp.maximum(dec, jnp.max(g, axis=-1))
        wg = jnp.exp(g - m_new[..., None])
        wd = jnp.exp(dec - m_new)
        C_new = wd[..., None, None] * C + jnp.einsum('bhs,bhse,bhsd->bhed', wg, vb, kb)
        n_new = wd[..., None] * n + jnp.einsum('bhs,bhsd->bhd', wg, kb)
        return (C_new, n_new, m_new), h

    (C, n, m), h = lax.scan(step, (C0, n0, m0), (qc, kc, vc, ic, lfc))
    h = jnp.moveaxis(h, 0, 1)
    h = jnp.moveaxis(h, 2, 3).reshape(B, T, H, -1)
    return h, C, n, m


def chunk_spatial_gate(u, v, w_s, b_s):
    B, T = v.shape[:2]
    Tp = -(-T // CM_CHUNK) * CM_CHUNK
    vp = jnp.pad(v, ((0, 0), (0, Tp - T), (0, 0), (0, 0)))
    vp = vp.reshape(B, Tp // CM_CHUNK, CM_CHUNK, CM_HEADS, CM_HEAD_DIM)
    w = jnp.where(jnp.tril(jnp.ones((CM_CHUNK, CM_CHUNK), dtype=bool))[None], w_s, jnp.zeros_like(w_s))
    s = jnp.einsum('hts,bcshe->bcthe', w, vp) + jnp.transpose(b_s)[None, None, :, :, None]
    s = s.reshape(B, Tp, CM_HEADS, CM_HEAD_DIM)[:, :T]
    return u * s


def hybrid_layer(x, c, C0, n0, m0, w_ada, b_ada, g_norm1, w_in, b_gate, g_mlstm_head,
                 ln_v_g, ln_v_b, w_s, b_s, w_out, g_norm2, w_gate_up, w_down):
    B, T, _ = x.shape
    mod = jax.nn.silu(c) @ w_ada + b_ada
    sh1, sc1, gt1, sh2, sc2, gt2 = [m_[:, None, :] for m_ in jnp.split(mod, N_MOD, axis=-1)]

    h = rmsnorm(x, g_norm1) * (1 + sc1) + sh1
    proj = h @ w_in
    q, k, vm, o, ig, fg, u, vs = split_cols(proj, IN_SIZES)
    f32 = jnp.float32
    q = q.reshape(B, T, ML_HEADS, ML_DK).astype(f32)
    k = k.reshape(B, T, ML_HEADS, ML_DK).astype(f32)
    vm = vm.reshape(B, T, ML_HEADS, ML_DV).astype(f32)
    i_pre = ig.astype(f32) + b_gate[:ML_HEADS].astype(f32)
    f_pre = fg.astype(f32) + b_gate[ML_HEADS:].astype(f32)
    h_ml, C, n, m = mlstm_chunkwise(q, k, vm, i_pre, f_pre,
                                    C0.astype(f32), n0.astype(f32), m0.astype(f32))
    h_ml = rmsnorm(h_ml.astype(x.dtype), g_mlstm_head)
    h_ml = h_ml * jax.nn.sigmoid(o.reshape(B, T, ML_HEADS, ML_DV))

    u = jax.nn.gelu(u).reshape(B, T, CM_HEADS, CM_HEAD_DIM)
    vs = layernorm(jax.nn.gelu(vs).reshape(B, T, CM_HEADS, CM_HEAD_DIM), ln_v_g, ln_v_b)
    h_cm = chunk_spatial_gate(u, vs, w_s, b_s)

    mix = jnp.concatenate([h_ml.reshape(B, T, ML_WIDTH), h_cm.reshape(B, T, CM_WIDTH)], axis=-1)
    x = x + gt1 * (mix @ w_out)

    h2 = rmsnorm(x, g_norm2) * (1 + sc2) + sh2
    a, bb = jnp.split(h2 @ w_gate_up, 2, axis=-1)
    x = x + gt2 * ((jax.nn.silu(a) * bb) @ w_down)
    return x, C, n, m, vs


def setup_inputs(seed: int = 0) -> dict:
    key = jax.random.key(seed)
    ks = jax.random.split(key, 24)
    f = jnp.float32
    nrm = lambda k_, s: jax.random.normal(k_, s, f)
    inp = {}
    inp['x_prompt'] = nrm(ks[0], (BATCH, SEQ, D_MODEL))
    inp['x_sample'] = nrm(ks[1], (DEC_BATCH, DEC_SEQ, D_MODEL))
    inp['c_prompt'] = nrm(ks[2], (BATCH, D_MODEL))
    inp['c_sample'] = nrm(ks[3], (DEC_BATCH, D_MODEL))
    inp['state_mlstm_C'] = 0.5 * nrm(ks[4], (DEPTH, DEC_BATCH, ML_HEADS, ML_DV, ML_DK))
    inp['state_mlstm_n'] = 0.5 * nrm(ks[5], (DEPTH, DEC_BATCH, ML_HEADS, ML_DK))
    inp['state_mlstm_m'] = nrm(ks[6], (DEPTH, DEC_BATCH, ML_HEADS))
    inp['w_ada'] = nrm(ks[7], (DEPTH, D_MODEL, N_MOD * D_MODEL)) * D_MODEL ** -0.5
    inp['b_ada'] = 0.02 * nrm(ks[8], (DEPTH, N_MOD * D_MODEL))
    inp['g_norm1'] = 1.0 + 0.05 * nrm(ks[9], (DEPTH, D_MODEL))
    inp['w_in'] = nrm(ks[10], (DEPTH, D_MODEL, N_IN)) * D_MODEL ** -0.5
    f_bias = jnp.broadcast_to(jnp.linspace(3.0, 6.0, ML_HEADS, dtype=f), (DEPTH, ML_HEADS))
    i_bias = 0.1 * nrm(ks[11], (DEPTH, ML_HEADS))
    inp['b_gate'] = jnp.concatenate([i_bias, f_bias + 0.05 * nrm(ks[12], (DEPTH, ML_HEADS))], axis=-1)
    inp['g_mlstm_head'] = 1.0 + 0.05 * nrm(ks[13], (DEPTH, ML_HEADS, ML_DV))
    inp['ln_v_g'] = 1.0 + 0.05 * nrm(ks[14], (DEPTH, CM_HEADS, CM_HEAD_DIM))
    inp['ln_v_b'] = 0.02 * nrm(ks[15], (DEPTH, CM_HEADS, CM_HEAD_DIM))
    inp['w_s'] = nrm(ks[16], (DEPTH, CM_HEADS, CM_CHUNK, CM_CHUNK)) * CM_CHUNK ** -0.5
    inp['b_s'] = 1.0 + 0.1 * nrm(ks[17], (DEPTH, CM_HEADS, CM_CHUNK))
    inp['w_out'] = nrm(ks[18], (DEPTH, MIX_WIDTH, D_MODEL)) * MIX_WIDTH ** -0.5
    inp['g_norm2'] = 1.0 + 0.05 * nrm(ks[19], (DEPTH, D_MODEL))
    inp['w_gate_up'] = nrm(ks[20], (DEPTH, D_MODEL, 2 * D_FF)) * D_MODEL ** -0.5
    inp['w_down'] = nrm(ks[21], (DEPTH, D_FF, D_MODEL)) * D_FF ** -0.5
    inp['g_final'] = 1.0 + 0.05 * nrm(ks[22], (D_MODEL,))
    return inp


def reference(x_prompt, x_sample, c_prompt, c_sample, state_mlstm_C, state_mlstm_n, state_mlstm_m,
              w_ada, b_ada, g_norm1, w_in, b_gate, g_mlstm_head, ln_v_g, ln_v_b, w_s, b_s,
              w_out, g_norm2, w_gate_up, w_down, g_final):
    f32 = jnp.float32
    xp, xs = x_prompt, x_sample
    Cp_l, np_l, mp_l, Cs_l, ns_l, ms_l, vs_l = [], [], [], [], [], [], []
    for l in range(DEPTH):
        params = (w_ada[l], b_ada[l], g_norm1[l], w_in[l], b_gate[l], g_mlstm_head[l], ln_v_g[l],
                  ln_v_b[l], w_s[l], b_s[l], w_out[l], g_norm2[l], w_gate_up[l], w_down[l])
        C0 = jnp.zeros((BATCH, ML_HEADS, ML_DV, ML_DK), f32)
        n0 = jnp.zeros((BATCH, ML_HEADS, ML_DK), f32)
        m0 = jnp.zeros((BATCH, ML_HEADS), f32)
        xp, Cp, n_p, mp, _ = hybrid_layer(xp, c_prompt, C0, n0, m0, *params)
        xs, Cs, n_s, ms, vs_new = hybrid_layer(xs, c_sample, state_mlstm_C[l], state_mlstm_n[l],
                                               state_mlstm_m[l], *params)
        Cp_l.append(Cp); np_l.append(n_p); mp_l.append(mp)
        Cs_l.append(Cs); ns_l.append(n_s); ms_l.append(ms); vs_l.append(vs_new)
    y_prompt = rmsnorm(xp, g_final)
    y_sample = rmsnorm(xs, g_final)
    return (y_prompt, y_sample,
            jnp.stack(Cp_l), jnp.stack(np_l), jnp.stack(mp_l),
            jnp.stack(Cs_l), jnp.stack(ns_l), jnp.stack(ms_l),
            jnp.stack(vs_l))
```

```cpp
#include <hip/hip_cooperative_groups.h>
#include <cstdio>
#include <hip/hip_runtime.h>
namespace pg8 {
#define PG8_LAS __attribute__((address_space(3)))
typedef unsigned short bf16_t;
typedef short bf16x8 __attribute__((ext_vector_type(8)));
typedef float f32x4 __attribute__((ext_vector_type(4)));
typedef unsigned u32x4 __attribute__((ext_vector_type(4)));
constexpr int BM = 256, BK = 64, HALF = 128, HTB = HALF * BK * 2  , STAGE_BYTES = 8 * HTB, NXCD = 8, WGM = 8;

__host__ __device__ __forceinline__ int lds_byte(int r, int c) { const int st = (r >> 4) * 2 + (c >> 5), rr = r & 15, cc = c & 31, ob = rr * 64 + cc * 2; return st * 1024 + (ob ^ (((ob >> 9) & 1) << 5)); }
__host__ __device__ __forceinline__ void stage_rc(int b, int& R, int& C) { const int st = b / 1024, sb = b % 1024, swz = sb ^ (((sb >> 9) & 1) << 5); R = (st >> 1) * 16 + swz / 64; C = (st & 1) * 32 + (swz % 64) / 2; }
__host__ __device__ __forceinline__ int perm32(int rho) { const int n = rho >> 4, i = rho & 15; return 8 * (i >> 2) + 4 * n + (i & 3); }

struct Unit { int pm, pn; };
struct Gemm { const bf16_t* A; const bf16_t* Bt; int M, N, K; };

struct StaticOrder {
    int nM, nN, nwg, G, c;
    __host__ __device__ void init(int M, int N, int G_, int c_) { nM = M / BM; nN = N / BM; nwg = nM * nN; G = G_; c = c_; }
    __host__ __device__ bool next(int i, Unit& u) const {
        const long L = (long)i * G + c; if (L >= nwg) return false;
        int wgid = (int)L; { const int q = nwg / NXCD, r = nwg % NXCD, xcd = wgid % NXCD, off = wgid / NXCD; wgid = (xcd < r ? xcd * (q + 1) : r * (q + 1) + (xcd - r) * q) + off; }
        const int nig = WGM * nN, gid = wgid / nig, fm = gid * WGM, gsz = (nM - fm) < WGM ? (nM - fm) : WGM;
        u.pm = fm + ((wgid % nig) % gsz); u.pn = (wgid % nig) / gsz; return true;
    }
    __device__ __forceinline__ void a_ready(const Unit&) const {}
    __device__ __forceinline__ void done(const Unit&) const {}
};
struct CountedOrder : StaticOrder {
    const unsigned* ready; unsigned need; unsigned* tmo;
    __device__ __forceinline__ void a_ready(const Unit& u) const {
        if (threadIdx.x < 64) {
            const unsigned long long t0 = __builtin_amdgcn_s_memrealtime(); unsigned polls = 0;
            while ((unsigned)__builtin_amdgcn_readfirstlane(__hip_atomic_load(ready + 64 * u.pm, __ATOMIC_RELAXED, __HIP_MEMORY_SCOPE_AGENT)) < need) {
                if ((++polls & 255u) == 0u && __builtin_amdgcn_readfirstlane(__hip_atomic_load(tmo, __ATOMIC_RELAXED, __HIP_MEMORY_SCOPE_AGENT)) != 0u) break;
                if (__builtin_amdgcn_s_memrealtime() - t0 > 2000000ull) {
                    if (threadIdx.x == 0) { unsigned expect = 0u; __hip_atomic_compare_exchange_strong(tmo + 1, &expect, 0x600u | (unsigned)(u.pm & 0xff), __ATOMIC_RELAXED, __ATOMIC_RELAXED, __HIP_MEMORY_SCOPE_AGENT); __hip_atomic_store(tmo, 1u, __ATOMIC_RELAXED, __HIP_MEMORY_SCOPE_AGENT); }
                    break; }
                __builtin_amdgcn_s_sleep(2); }
            __builtin_amdgcn_fence(__ATOMIC_ACQUIRE, "agent");
            asm volatile("s_waitcnt vmcnt(0)" ::: "memory");
        }
#if !defined(BROKEN_HOOK_NO_BARRIER)
        asm volatile("" ::: "memory"); __builtin_amdgcn_s_barrier(); asm volatile("" ::: "memory");
#endif
    }
};

template <class Epi, class Sched, bool STAMP = false>
__device__ __forceinline__ void gemm_phase(PG8_LAS unsigned char* lds, const Gemm g, const Sched& S, const Epi& E, unsigned long long* stamps) {
    const int tid = threadIdx.x, wid = __builtin_amdgcn_readfirstlane(tid >> 6), lane = tid & 63, wr = wid >> 2, wc = wid & 3, fr = lane & 15, fq = lane >> 4;
    const int K = g.K, nt = K / BK;
    int ts_lo = 0, ts_hi = 0, nts = 0; const unsigned long long rt_entry = STAMP ? (unsigned long long)wall_clock64() : 0ull;
#define PG8_STAMP() do { if (STAMP && wid == 0 && nts < 64) { const unsigned long long _c = (unsigned long long)clock64(); \
        ts_lo = (lane == nts) ? (int)(unsigned)_c : ts_lo; ts_hi = (lane == nts) ? (int)(unsigned)(_c >> 32) : ts_hi; ++nts; } } while (0)
    PG8_STAMP();
    unsigned voffA[2], voffB[2];
#pragma unroll
    for (int i = 0; i < 2; ++i) { int R, C; stage_rc(tid * 16 + i * 8192, R, C); const int Rb = Epi::PERM ? ((R & ~31) + perm32(R & 31)) : R;
        voffA[i] = (unsigned)(R * K + C) * 2u; voffB[i] = (unsigned)(Rb * K + C) * 2u; }
    const size_t kstep = (size_t)(BK * 2);
    const size_t hstep = (size_t)HALF * K * 2;
    const size_t tstep = 2 * hstep;
    const unsigned ldsw = (unsigned)wid * 1024u;
    const int aoff = lds_byte(wr * 64 + fr, fq * 8), boff = lds_byte(wc * 32 + fr, fq * 8);
#define PG8_SA(b, h) (((b) * 2 + (h)) * HTB)
#define PG8_SB(b, h) ((4 + (b) * 2 + (h)) * HTB)
#define PG8_STAGE(bufoff, gbase, voff) do { _Pragma("unroll") for (int _i = 0; _i < 2; ++_i) \
        __builtin_amdgcn_global_load_lds((const unsigned*)((const char*)(gbase) + (voff)[_i]), (PG8_LAS unsigned*)(lds + (bufoff) + ldsw + _i * 8192), 16, 0, 0); } while (0)
#define PG8_LDA(dst, b, h) do { _Pragma("unroll") for (int m = 0; m < 4; ++m) _Pragma("unroll") for (int k = 0; k < 2; ++k) dst[m][k] = *(const PG8_LAS bf16x8*)(lds + PG8_SA(b, h) + aoff + m * 2048 + k * 1024); } while (0)
#define PG8_LDB(dst, b, h) do { _Pragma("unroll") for (int n = 0; n < 2; ++n) _Pragma("unroll") for (int k = 0; k < 2; ++k) dst[n][k] = *(const PG8_LAS bf16x8*)(lds + PG8_SB(b, h) + boff + n * 2048 + k * 1024); } while (0)
#define PG8_MMA(ai, bj, At, Bt) do { __builtin_amdgcn_s_setprio(1); _Pragma("unroll") for (int m = 0; m < 4; ++m) _Pragma("unroll") for (int n = 0; n < 2; ++n) _Pragma("unroll") for (int k = 0; k < 2; ++k) \
        acc[ai][bj][m][n] = __builtin_amdgcn_mfma_f32_16x16x32_bf16(Bt[n][k], At[m][k], acc[ai][bj][m][n], 0, 0, 0); __builtin_amdgcn_s_setprio(0); } while (0)
#define PG8_WAIT_V(n) asm volatile("s_waitcnt vmcnt(" #n ")" ::: "memory")
#define PG8_WAIT_L(n) asm volatile("s_waitcnt lgkmcnt(" #n ")" ::: "memory")
#define PG8_BAR __builtin_amdgcn_s_barrier()
#define PG8_SCHED __builtin_amdgcn_sched_barrier(0)
    Unit cur, nxt; int ui = 0;
    if (!S.next(0, cur)) return;
    f32x4 acc[2][2][4][2];
#pragma unroll
    for (int a = 0; a < 2; ++a)
#pragma unroll
        for (int b = 0; b < 2; ++b)
#pragma unroll
            for (int m = 0; m < 4; ++m)
#pragma unroll
                for (int n = 0; n < 2; ++n) acc[a][b][m][n] = (f32x4){0.f, 0.f, 0.f, 0.f};
    bf16x8 At[4][2], B0[2][2], B1[2][2];
    const char* cA = (const char*)g.A + (size_t)cur.pm * tstep; const char* cB = (const char*)g.Bt + (size_t)cur.pn * tstep;
    S.a_ready(cur);
    PG8_STAGE(PG8_SB(0, 0), cB, voffB); PG8_STAGE(PG8_SA(0, 0), cA, voffA); PG8_STAGE(PG8_SB(0, 1), cB + hstep, voffB); PG8_STAGE(PG8_SA(0, 1), cA + hstep, voffA);
    if (wr == 1) PG8_BAR;
    PG8_WAIT_V(4); PG8_BAR;
    PG8_STAGE(PG8_SB(1, 0), cB + kstep, voffB); PG8_STAGE(PG8_SA(1, 0), cA + kstep, voffA); PG8_STAGE(PG8_SB(1, 1), cB + hstep + kstep, voffB);
    PG8_WAIT_V(6); PG8_BAR;
    PG8_STAMP();
    for (;;) {
        const bool has_next = S.next(ui + 1, nxt);
        const char* nA = has_next ? (const char*)g.A + (size_t)nxt.pm * tstep : cA; const char* nB = has_next ? (const char*)g.Bt + (size_t)nxt.pn * tstep : cB;
        for (int t = 0; t < nt; t += 2) {
            const bool last = (t == nt - 2);
            const char* a1 = cA + (size_t)(t + 1) * kstep;
            const char* a2 = last ? nA : cA + (size_t)(t + 2) * kstep; const char* b2 = last ? nB : cB + (size_t)(t + 2) * kstep;
            const char* a3 = a2 + kstep; const char* b3 = b2 + kstep;
            if (last && has_next) S.a_ready(nxt);
            PG8_LDB(B0, 0, 0); PG8_SCHED; PG8_LDA(At, 0, 0); PG8_STAGE(PG8_SA(1, 1), a1 + hstep, voffA);
            PG8_WAIT_L(8); PG8_BAR; PG8_WAIT_L(0); PG8_MMA(0, 0, At, B0); PG8_BAR; PG8_SCHED;
            PG8_LDB(B1, 0, 1); PG8_STAGE(PG8_SB(0, 0), b2, voffB);
            PG8_BAR; PG8_WAIT_L(0); PG8_MMA(0, 1, At, B1); PG8_BAR;
            PG8_LDA(At, 0, 1); PG8_STAGE(PG8_SA(0, 0), a2, voffA);
            PG8_BAR; PG8_WAIT_L(0); PG8_MMA(1, 0, At, B0); PG8_BAR; PG8_SCHED;
            PG8_STAGE(PG8_SB(0, 1), b2 + hstep, voffB);
            PG8_WAIT_V(6); PG8_BAR; PG8_MMA(1, 1, At, B1); PG8_BAR;
            PG8_LDB(B0, 1, 0); PG8_SCHED; PG8_LDA(At, 1, 0); PG8_STAGE(PG8_SA(0, 1), a2 + hstep, voffA);
            PG8_WAIT_L(8); PG8_BAR; PG8_WAIT_L(0); PG8_MMA(0, 0, At, B0); PG8_BAR; PG8_SCHED;
            PG8_LDB(B1, 1, 1); PG8_STAGE(PG8_SB(1, 0), b3, voffB);
            PG8_BAR; PG8_WAIT_L(0); PG8_MMA(0, 1, At, B1); PG8_BAR;
            PG8_LDA(At, 1, 1); PG8_STAGE(PG8_SA(1, 0), a3, voffA);
            PG8_BAR; PG8_WAIT_L(0); PG8_MMA(1, 0, At, B0); PG8_BAR; PG8_SCHED;
            PG8_STAGE(PG8_SB(1, 1), b3 + hstep, voffB);
            PG8_WAIT_V(6); PG8_BAR; PG8_MMA(1, 1, At, B1); PG8_BAR;
        }
        PG8_STAMP();
        if constexpr (!Epi::AFTER_DRAIN) { E(acc, cur, wr, wc, fr, fq); S.done(cur); }
        PG8_STAMP();
        if (!has_next) break;
#pragma unroll
        for (int a = 0; a < 2; ++a)
#pragma unroll
            for (int b = 0; b < 2; ++b)
#pragma unroll
                for (int m = 0; m < 4; ++m)
#pragma unroll
                    for (int n = 0; n < 2; ++n) acc[a][b][m][n] = (f32x4){0.f, 0.f, 0.f, 0.f};
        cur = nxt; cA = nA; cB = nB; ++ui;
    }
    PG8_WAIT_V(0);
    if (wr == 0) PG8_BAR;
    PG8_BAR;
    if constexpr (Epi::AFTER_DRAIN) { E.fused(acc, cur, wr, wc, fr, fq, lds, wid, lane); S.done(cur); }
    PG8_STAMP();
    if (STAMP && wid == 0) { stamps[lane] = lane < nts ? (((unsigned long long)(unsigned)ts_hi << 32) | (unsigned)ts_lo) : 0ull;
        if (lane == 62) stamps[62] = rt_entry; if (lane == 63) stamps[63] = (unsigned long long)wall_clock64(); }
#undef PG8_STAMP
#undef PG8_SA
#undef PG8_SB
#undef PG8_STAGE
#undef PG8_LDA
#undef PG8_LDB
#undef PG8_MMA
#undef PG8_WAIT_V
#undef PG8_WAIT_L
#undef PG8_BAR
#undef PG8_SCHED
}
}
namespace cg = cooperative_groups;
using pg8::Unit;
#define LAS __attribute__((address_space(3)))
typedef LAS unsigned char lds_u8;
typedef unsigned short bf16_t;
typedef short bf16x8 __attribute__((ext_vector_type(8)));
typedef float f32x4 __attribute__((ext_vector_type(4)));
typedef unsigned u32x4 __attribute__((ext_vector_type(4)));
typedef unsigned u32x2 __attribute__((ext_vector_type(2)));

constexpr int D = 1024, TP = 16384, TS = 128, ROWS = TP + TS, NIN = 3080, NP = 3072, DFF = 2816, NMOD = 6144;
constexpr float LOG2E = 1.4426950408889634f;
constexpr int LDS_BYTES = 131072 + 8192;
constexpr size_t WS_WIN = 0, WS_WOUT = 6291456, WS_WGU = 8388608, WS_WD = 19922944, WS_ADA_CST = 25690112, WS_SC = 42467328,
    WS_MOD = 42762240, WS_GATES = 46104576, WS_H = 46632960, WS_PROJ = 80711680, WS_MIX = 182947840, WS_VEC = 217026560;
constexpr size_t WS_BV = WS_VEC, WS_AV = WS_VEC + 262144, WS_PM = WS_VEC + 2 * 262144, WS_NLOC = WS_VEC + 3 * 262144, WS_NST = WS_VEC + 4 * 262144,
    WS_BC = WS_VEC + 5 * 262144, WS_PC = WS_BC + 2048, WS_MST = WS_PC + 2048, WS_END = WS_MST + 2048;
constexpr size_t O_Y = 0, O_CP = 16908288, O_NP = 17432576, O_MP = 17436672, O_CS = 17436704, O_NS = 25825312, O_MS = 25890848, O_VS = 25891360;

struct Params { const float* in[22]; float* out; unsigned char* ws; int ph_lo, ph_hi; };

__device__ __forceinline__ unsigned cvt_pk_bf16(float lo, float hi) { unsigned r; asm("v_cvt_pk_bf16_f32 %0, %1, %2" : "=v"(r) : "v"(lo), "v"(hi)); return r; }
__device__ __forceinline__ float bflo(unsigned w) { return __uint_as_float(w << 16); }
__device__ __forceinline__ float bfhi(unsigned w) { return __uint_as_float(w & 0xffff0000u); }
__device__ __forceinline__ float fexp(float x) { return __builtin_amdgcn_exp2f(x * LOG2E); }
__device__ __forceinline__ float sigm(float x) { return __builtin_amdgcn_rcpf(1.0f + fexp(-x)); }
__device__ __forceinline__ float gelu_t(float x) { return x * sigm(1.5957691216057308f * x * (1.0f + 0.044715f * x * x)); }
__device__ __forceinline__ float logsig(float f) { return fminf(f, 0.f) - log1pf(expf(-fabsf(f))); }
__device__ __forceinline__ float wsum(float v) { for (int o = 32; o >= 1; o >>= 1) v += __shfl_xor(v, o); return v; }
__device__ __forceinline__ int mod_row(int row) { return row < TP ? (row >> 11) : (8 + row - TP); }

__device__ __forceinline__ f32x4 proj_act(int seg, f32x4 v) {
    if (seg == 0) { v *= 0.08838834764831845f; }
    else if (seg == 3) { for (int j = 0; j < 4; ++j) v[j] = sigm(v[j]); }
    else if (seg >= 4) { for (int j = 0; j < 4; ++j) v[j] = gelu_t(v[j]); }
    return v;
}
struct EpiProj {
    static constexpr bool PERM = false, AFTER_DRAIN = false;
    bf16_t* P;
    __device__ __forceinline__ void operator()(const f32x4 (&acc)[2][2][4][2], const Unit& u, int wr, int wc, int fr, int fq) const {
        const int seg = u.pn >> 1; const int row0 = u.pm * 256 + wr * 64 + fr, col0 = u.pn * 256 + wc * 32 + 4 * fq;
#pragma unroll
        for (int ai = 0; ai < 2; ++ai)
#pragma unroll
            for (int m = 0; m < 4; ++m) { bf16_t* rowp = P + (size_t)(row0 + ai * 128 + m * 16) * NP + col0;
#pragma unroll
                for (int bj = 0; bj < 2; ++bj)
#pragma unroll
                    for (int n = 0; n < 2; ++n) { const f32x4 v = proj_act(seg, acc[ai][bj][m][n]); u32x2 w; w.x = cvt_pk_bf16(v[0], v[1]); w.y = cvt_pk_bf16(v[2], v[3]);
                        *(u32x2*)(rowp + bj * 128 + n * 16) = w; } }
    }
    __device__ __forceinline__ void small(int row, int col, f32x4 v) const { v = proj_act(col >> 9, v); u32x2 w; w.x = cvt_pk_bf16(v[0], v[1]); w.y = cvt_pk_bf16(v[2], v[3]); *(u32x2*)(P + (size_t)row * NP + col) = w; }
};
struct EpiRes {
    static constexpr bool PERM = false, AFTER_DRAIN = false;
    const float* x; const float* gate; float* o;
    __device__ __forceinline__ void operator()(const f32x4 (&acc)[2][2][4][2], const Unit& u, int wr, int wc, int fr, int fq) const {
        const int row0 = u.pm * 256 + wr * 64 + fr, col0 = u.pn * 256 + wc * 32 + 4 * fq; const float* gp = gate + (size_t)(u.pm >> 3) * NMOD + col0;
        f32x4 g[2][2];
#pragma unroll
        for (int bj = 0; bj < 2; ++bj)
#pragma unroll
            for (int n = 0; n < 2; ++n) g[bj][n] = *(const f32x4*)(gp + bj * 128 + n * 16);
#pragma unroll
        for (int ai = 0; ai < 2; ++ai)
#pragma unroll
            for (int m = 0; m < 4; ++m) { const size_t off = (size_t)(row0 + ai * 128 + m * 16) * D + col0;
#pragma unroll
                for (int bj = 0; bj < 2; ++bj)
#pragma unroll
                    for (int n = 0; n < 2; ++n) { const f32x4 xv = *(const f32x4*)(x + off + bj * 128 + n * 16); *(f32x4*)(o + off + bj * 128 + n * 16) = xv + g[bj][n] * acc[ai][bj][m][n]; }
                asm volatile("" ::: "memory"); }
    }
};
struct EpiSwi {
    static constexpr bool PERM = false, AFTER_DRAIN = false;
    bf16_t* A;
    __device__ __forceinline__ void operator()(const f32x4 (&acc)[2][2][4][2], const Unit& u, int wr, int wc, int fr, int fq) const {
        const int row0 = u.pm * 256 + wr * 64 + fr, col0 = u.pn * 128 + wc * 32 + 4 * fq;
#pragma unroll
        for (int ai = 0; ai < 2; ++ai)
#pragma unroll
            for (int m = 0; m < 4; ++m) { bf16_t* rowp = A + (size_t)(row0 + ai * 128 + m * 16) * DFF + col0;
#pragma unroll
                for (int n = 0; n < 2; ++n) { const f32x4 a = acc[ai][0][m][n], b = acc[ai][1][m][n]; f32x4 r;
#pragma unroll
                    for (int j = 0; j < 4; ++j) r[j] = a[j] * sigm(a[j]) * b[j];
                    u32x2 w; w.x = cvt_pk_bf16(r[0], r[1]); w.y = cvt_pk_bf16(r[2], r[3]); *(u32x2*)(rowp + n * 16) = w; } }
    }
};

template <int RT, int KS, bool DUAL, class F>
__device__ __forceinline__ void sgemm_unit(LAS f32x4* red, const bf16_t* A, const bf16_t* Bt, int K, int rt0, int nrt, int brow0, int brow_dual, const F& f) {
    const int tid = threadIdx.x, wid = tid >> 6, lane = tid & 63, fr = lane & 15, fq = lane >> 4, rtl = wid % RT, ks = wid / RT;
    const int kb = ks * (K / KS), ke = kb + K / KS;
    for (int rt = rt0 + rtl; rt < rt0 + nrt; rt += RT) {
        f32x4 acc = {0.f, 0.f, 0.f, 0.f}, acc2 = {0.f, 0.f, 0.f, 0.f};
        const bf16_t* ap = A + (size_t)(rt * 16 + fr) * K + fq * 8; const bf16_t* bp = Bt + (size_t)(brow0 + fr) * K + fq * 8; const bf16_t* bp2 = Bt + (size_t)(brow_dual + fr) * K + fq * 8;
#pragma unroll 4
        for (int k = kb; k < ke; k += 32) {
            const bf16x8 a = *(const bf16x8*)(ap + k), b = *(const bf16x8*)(bp + k);
            acc = __builtin_amdgcn_mfma_f32_16x16x32_bf16(b, a, acc, 0, 0, 0);
            if (DUAL) { const bf16x8 b2 = *(const bf16x8*)(bp2 + k); acc2 = __builtin_amdgcn_mfma_f32_16x16x32_bf16(b2, a, acc2, 0, 0, 0); }
        }
        if (KS > 1) {
            red[wid * 64 + lane] = acc; __syncthreads();
            if (ks == 0) { for (int s = 1; s < KS; ++s) acc += red[(rtl + RT * s) * 64 + lane]; }
            __syncthreads();
            if (ks != 0) continue;
        }
        f(rt * 16 + fr, 4 * fq, acc, acc2);
    }
}
__device__ __forceinline__ void conv_unit(LAS float* T, const float* src, int ld_src, int k0, int c0, bf16_t* dst, int ldd, int n0) {
    const int tid = threadIdx.x; const int l16 = tid & 15, kr = tid >> 4;
#pragma unroll
    for (int ps = 0; ps < 2; ++ps) { const int kk = kr + 32 * ps; const f32x4 v = *(const f32x4*)(src + (size_t)(k0 + kk) * ld_src + c0 + 4 * l16);
#pragma unroll
        for (int i = 0; i < 4; ++i) T[kk * 65 + 4 * l16 + i] = v[i]; }
    __syncthreads();
    const int kg = tid & 7, n = tid >> 3; float v[8];
#pragma unroll
    for (int i = 0; i < 8; ++i) v[i] = T[(8 * kg + i) * 65 + n];
    u32x4 w; w.x = cvt_pk_bf16(v[0], v[1]); w.y = cvt_pk_bf16(v[2], v[3]); w.z = cvt_pk_bf16(v[4], v[5]); w.w = cvt_pk_bf16(v[6], v[7]);
    *(u32x4*)(dst + (size_t)(n0 + n) * ldd + k0 + 8 * kg) = w;
    __syncthreads();
}
__device__ void phase_convert(const Params& p, lds_u8* L) {
    LAS float* T = (LAS float*)L; unsigned char* ws = p.ws;
    const int NU = 4672 + 72;
    for (int u = blockIdx.x; u < NU; u += gridDim.x) {
        if (u < 768) { const int kb = u / 48, nb = u % 48; const int c0 = nb * 64 + (nb >= 32 ? 8 : 0); conv_unit(T, p.in[10], NIN, kb * 64, c0, (bf16_t*)(ws + WS_WIN), D, nb * 64); }
        else if (u < 1024) { const int v = u - 768, kb = v / 16, nb = v % 16; conv_unit(T, p.in[17], D, kb * 64, nb * 64, (bf16_t*)(ws + WS_WOUT), D, nb * 64); }
        else if (u < 2432) { const int v = u - 1024, kb = v / 88, nb = v % 88; const int tile = nb >> 2, q4 = nb & 3; const int c0 = (q4 < 2) ? tile * 128 + q4 * 64 : DFF + tile * 128 + (q4 - 2) * 64;
            conv_unit(T, p.in[19], 2 * DFF, kb * 64, c0, (bf16_t*)(ws + WS_WGU), D, nb * 64); }
        else if (u < 3136) { const int v = u - 2432, kb = v / 16, nb = v % 16; conv_unit(T, p.in[20], D, kb * 64, nb * 64, (bf16_t*)(ws + WS_WD), DFF, nb * 64); }
        else if (u < 4672) { const int v = u - 3136, kb = v / 96, nb = v % 96; conv_unit(T, p.in[7], NMOD, kb * 64, nb * 64, (bf16_t*)(ws + WS_ADA_CST), D, nb * 64); }
        else { const int v = u - 4672; const int idx = v * 512 + threadIdx.x;
            const int r = idx >> 8, c = (idx & 255) * 4; f32x4 x = {0.f, 0.f, 0.f, 0.f};
            if (r < 8) x = *(const f32x4*)(p.in[2] + r * D + c); else if (r < 136) x = *(const f32x4*)(p.in[3] + (r - 8) * D + c);
            u32x2 w; w.x = cvt_pk_bf16(x[0] * sigm(x[0]), x[1] * sigm(x[1])); w.y = cvt_pk_bf16(x[2] * sigm(x[2]), x[3] * sigm(x[3]));
            *(u32x2*)((bf16_t*)(ws + WS_SC) + r * D + c) = w; }
    }
}

template <int MODE> __device__ void phase_norm(const Params& p) {
    const int lane = threadIdx.x & 63, gw = blockIdx.x * 8 + (threadIdx.x >> 6), nW = gridDim.x * 8;
    const float* mod = (const float*)(p.ws + WS_MOD); bf16_t* H = (bf16_t*)(p.ws + WS_H); float* gates = (float*)(p.ws + WS_GATES);
    const float* gain = MODE == 0 ? p.in[9] : (MODE == 1 ? p.in[18] : p.in[21]);
    f32x4 gv[4];
#pragma unroll
    for (int j = 0; j < 4; ++j) gv[j] = *(const f32x4*)(gain + 4 * lane + 256 * j);
    f32x4 wg[4][4][2];
    if (MODE == 0) {
#pragma unroll
        for (int j = 0; j < 4; ++j)
#pragma unroll
            for (int i = 0; i < 4; ++i) { const float* wp = p.in[10] + (size_t)(4 * lane + 256 * j + i) * NIN + 2048; wg[j][i][0] = *(const f32x4*)wp; wg[j][i][1] = *(const f32x4*)(wp + 4); }
    }
    for (int r = gw; r < ROWS; r += nW) {
        const float* src = MODE == 0 ? (r < TP ? p.in[0] + (size_t)r * D : p.in[1] + (size_t)(r - TP) * D) : p.out + (size_t)r * D;
        f32x4 xv[4]; float ss = 0.f;
#pragma unroll
        for (int j = 0; j < 4; ++j) { xv[j] = *(const f32x4*)(src + 4 * lane + 256 * j); ss += xv[j][0] * xv[j][0] + xv[j][1] * xv[j][1] + xv[j][2] * xv[j][2] + xv[j][3] * xv[j][3]; }
        ss = wsum(ss); const float rstd = 1.0f / sqrtf(ss * (1.0f / 1024.0f) + 1e-6f);
        if (MODE == 2) {
#pragma unroll
            for (int j = 0; j < 4; ++j) *(f32x4*)(p.out + (size_t)r * D + 4 * lane + 256 * j) = xv[j] * rstd * gv[j];
        } else {
            const float* mp = mod + (size_t)mod_row(r) * NMOD + (MODE == 0 ? 0 : 3072);
            f32x4 ga = {0.f, 0.f, 0.f, 0.f}, gb = {0.f, 0.f, 0.f, 0.f};
#pragma unroll
            for (int j = 0; j < 4; ++j) { const f32x4 sh = *(const f32x4*)(mp + 4 * lane + 256 * j), sc = *(const f32x4*)(mp + 1024 + 4 * lane + 256 * j);
                const f32x4 h = xv[j] * rstd * gv[j] * (1.0f + sc) + sh;
                u32x2 w; w.x = cvt_pk_bf16(h[0], h[1]); w.y = cvt_pk_bf16(h[2], h[3]); *(u32x2*)(H + (size_t)r * D + 4 * lane + 256 * j) = w;
                if (MODE == 0) {
#pragma unroll
                    for (int i = 0; i < 4; ++i) { ga += h[i] * wg[j][i][0]; gb += h[i] * wg[j][i][1]; } } }
            if (MODE == 0) {
#pragma unroll
                for (int i = 0; i < 4; ++i) { ga[i] = wsum(ga[i]); gb[i] = wsum(gb[i]); }
                if (lane == 0) { const f32x4 b0 = *(const f32x4*)(p.in[11]), b1 = *(const f32x4*)(p.in[11] + 4); *(f32x4*)(gates + (size_t)r * 8) = ga + b0; *(f32x4*)(gates + (size_t)r * 8 + 4) = gb + b1; }
            }
        }
    }
}

__device__ __forceinline__ int t128(int n, int k8) { return n * 256 + ((k8 ^ ((n ^ (n >> 3)) & 15)) << 4); }
__device__ __forceinline__ void stage_nat(lds_u8* T, const bf16_t* src, int ld) {
#pragma unroll
    for (int i = 0; i < 4; ++i) { const int g = threadIdx.x + 512 * i, n = g >> 4, k8 = g & 15; *(LAS u32x4*)(T + t128(n, k8)) = *(const u32x4*)(src + (size_t)n * ld + k8 * 8); }
}
template <class F> __device__ __forceinline__ void stage_T(lds_u8* T, const bf16_t* src, int ld, const F& xf) {
    const int rg = threadIdx.x >> 4, cg = threadIdx.x & 15; u32x4 r[4];
#pragma unroll
    for (int j = 0; j < 4; ++j) r[j] = *(const u32x4*)(src + (size_t)(4 * rg + j) * ld + 8 * cg);
#pragma unroll
    for (int i = 0; i < 8; ++i) { float v[4];
#pragma unroll
        for (int j = 0; j < 4; ++j) { const unsigned w = r[j][i >> 1]; v[j] = xf(4 * rg + j, 8 * cg + i, (i & 1) ? bfhi(w) : bflo(w)); }
        u32x2 o; o.x = cvt_pk_bf16(v[0], v[1]); o.y = cvt_pk_bf16(v[2], v[3]);
        const int n = 8 * cg + i; *(LAS u32x2*)(T + n * 256 + ((((rg >> 1)) ^ ((n ^ (n >> 3)) & 15)) << 4) + (rg & 1) * 8) = o; }
}
__device__ __forceinline__ void mm16(f32x4 (&acc)[8], const lds_u8* A, int arow0, const lds_u8* B, int fr, int fq) {
#pragma unroll 1
    for (int ks = 0; ks < 4; ++ks) { const bf16x8 a = *(const LAS bf16x8*)(A + t128(arow0 + fr, 4 * ks + fq));
#pragma unroll
        for (int n = 0; n < 8; ++n) { const bf16x8 b = *(const LAS bf16x8*)(B + t128(16 * n + fr, 4 * ks + fq)); acc[n] = __builtin_amdgcn_mfma_f32_16x16x32_bf16(b, a, acc[n], 0, 0, 0); } }
}
#define T_(i) (L + (i) * 32768)
#define SMF ((LAS float*)(L + 131072))

__device__ void mlstm_pass1(const Params& p, lds_u8* L, int item) {
    const int tid = threadIdx.x, wid = tid >> 6, lane = tid & 63, fr = lane & 15, fq = lane >> 4;
    const int bh = item >> 4, c = item & 15, b = bh >> 2, h = bh & 3, row0 = b * 2048 + c * 128;
    const bf16_t* P = (const bf16_t*)(p.ws + WS_PROJ) + (size_t)row0 * NP; const float* G = (const float*)(p.ws + WS_GATES) + (size_t)row0 * 8;
    LAS float* av = SMF; LAS float* wgv = SMF + 128;
    if (wid == 0) {
        const int t0 = 2 * lane; const float i0 = G[t0 * 8 + h], i1 = G[(t0 + 1) * 8 + h], lf0 = logsig(G[t0 * 8 + 4 + h]), lf1 = logsig(G[(t0 + 1) * 8 + 4 + h]);
        float s = lf0 + lf1;
        for (int o = 1; o < 64; o <<= 1) { const float t = __shfl_up(s, o); if (lane >= o) s += t; }
        const float b1 = s, b0 = s - lf1, a0 = i0 - b0, a1 = i1 - b1;
        float q = fmaxf(a0, a1);
        for (int o = 1; o < 64; o <<= 1) { const float t = __shfl_up(q, o); if (lane >= o) q = fmaxf(q, t); }
        float ex = __shfl_up(q, 1); if (lane == 0) ex = -INFINITY;
        const float pm0 = fmaxf(ex, a0), pm1 = q;
        float* bv_g = (float*)(p.ws + WS_BV) + item * 128; float* av_g = (float*)(p.ws + WS_AV) + item * 128; float* pm_g = (float*)(p.ws + WS_PM) + item * 128;
        bv_g[t0] = b0; bv_g[t0 + 1] = b1; av_g[t0] = a0; av_g[t0 + 1] = a1; pm_g[t0] = pm0; pm_g[t0 + 1] = pm1;
        const float PC = __shfl(q, 63);
        av[t0] = a0; av[t0 + 1] = a1; wgv[t0] = fexp(a0 - PC); wgv[t0 + 1] = fexp(a1 - PC);
        if (lane == 63) { ((float*)(p.ws + WS_BC))[item] = b1; ((float*)(p.ws + WS_PC))[item] = q; }
    }
    __syncthreads();
    stage_T(T_(2), P + 1024 + h * 128, NP, [&](int s, int, float v) { return v * wgv[s]; });
    stage_T(T_(1), P + 512 + h * 128, NP, [&](int, int, float v) { return v; });
    __syncthreads();
    f32x4 acc[8];
#pragma unroll
    for (int n = 0; n < 8; ++n) acc[n] = (f32x4){0.f, 0.f, 0.f, 0.f};
    mm16(acc, T_(2), 16 * wid, T_(1), fr, fq);
    float* cl = (float*)(p.ws + WS_H) + (size_t)item * 16384 + (16 * wid + fr) * 128 + 4 * fq;
#pragma unroll
    for (int n = 0; n < 8; ++n) *(f32x4*)(cl + 16 * n) = acc[n];
    { const int d = tid >> 2, q4 = tid & 3; float s = 0.f;
#pragma unroll
        for (int g = 0; g < 4; ++g) { const u32x4 w = *(const LAS u32x4*)(T_(1) + t128(d, 4 * q4 + g)); const int s0 = 32 * q4 + 8 * g;
#pragma unroll
            for (int i = 0; i < 4; ++i) s += bflo(w[i]) * wgv[s0 + 2 * i] + bfhi(w[i]) * wgv[s0 + 2 * i + 1]; }
        s += __shfl_xor(s, 1); s += __shfl_xor(s, 2);
        if (q4 == 0) ((float*)(p.ws + WS_NLOC))[item * 128 + d] = s; }
    __syncthreads();
}

__device__ void sample_item(const Params& p, lds_u8* L, int it) {
    const int tid = threadIdx.x, wid = tid >> 6, lane = tid & 63; const int bs = it >> 2, h = it & 3, row = TP + bs;
    const bf16_t* P = (const bf16_t*)(p.ws + WS_PROJ) + (size_t)row * NP; const float* G = (const float*)(p.ws + WS_GATES) + (size_t)row * 8;
    bf16_t* MIX = (bf16_t*)(p.ws + WS_MIX) + (size_t)row * D;
    LAS float* hb = SMF; LAS float* vsh = SMF + 128;
    const float ig = G[h], lf = logsig(G[4 + h]), m0 = p.in[6][bs * 4 + h];
    const float inter = lf + m0, mt = fmaxf(inter, ig), wi = fexp(ig - mt), wd = fexp(inter - mt);
    const int d4 = (lane & 31) * 4;
    float q4[4], k4[4];
    { const u32x2 qw = *(const u32x2*)(P + h * 128 + d4), kw = *(const u32x2*)(P + 512 + h * 128 + d4);
      q4[0] = bflo(qw.x); q4[1] = bfhi(qw.x); q4[2] = bflo(qw.y); q4[3] = bfhi(qw.y); k4[0] = bflo(kw.x); k4[1] = bfhi(kw.x); k4[2] = bflo(kw.y); k4[3] = bfhi(kw.y); }
    float qk = q4[0] * k4[0] + q4[1] * k4[1] + q4[2] * k4[2] + q4[3] * k4[3];
    for (int o = 16; o >= 1; o >>= 1) qk += __shfl_xor(qk, o);
    const f32x4 n0 = *(const f32x4*)(p.in[5] + (size_t)(bs * 4 + h) * 128 + d4);
    float nq = n0[0] * q4[0] + n0[1] * q4[1] + n0[2] * q4[2] + n0[3] * q4[3];
    for (int o = 16; o >= 1; o >>= 1) nq += __shfl_xor(nq, o);
    if (tid < 128) vsh[tid] = __uint_as_float(((unsigned)P[1024 + h * 128 + tid]) << 16);
    __syncthreads();
    const float s = qk * wi;
    const float* C0 = p.in[4] + (size_t)(bs * 4 + h) * 16384; float* C1 = p.out + O_CS + (size_t)(bs * 4 + h) * 16384;
#pragma unroll
    for (int i = 0; i < 8; ++i) { const int e = 16 * wid + 2 * i + (lane >> 5); const f32x4 cv = *(const f32x4*)(C0 + e * 128 + d4); const float ve = vsh[e];
        float cq = cv[0] * q4[0] + cv[1] * q4[1] + cv[2] * q4[2] + cv[3] * q4[3];
        for (int o = 16; o >= 1; o >>= 1) cq += __shfl_xor(cq, o);
        f32x4 cn; cn[0] = wd * cv[0] + wi * ve * k4[0]; cn[1] = wd * cv[1] + wi * ve * k4[1]; cn[2] = wd * cv[2] + wi * ve * k4[2]; cn[3] = wd * cv[3] + wi * ve * k4[3];
        *(f32x4*)(C1 + e * 128 + d4) = cn;
        if ((lane & 31) == 0) hb[e] = s * ve + wd * cq; }
    __syncthreads();
    if (wid == 0) {
        if (lane < 32) { f32x4 nn; nn[0] = wd * n0[0] + wi * k4[0]; nn[1] = wd * n0[1] + wi * k4[1]; nn[2] = wd * n0[2] + wi * k4[2]; nn[3] = wd * n0[3] + wi * k4[3];
            *(f32x4*)(p.out + O_NS + (size_t)(bs * 4 + h) * 128 + d4) = nn; }
        if (lane == 0) p.out[O_MS + bs * 4 + h] = mt;
        const float den = s + wd * nq, dn = fmaxf(fabsf(den), fexp(-mt)); const int e = 2 * lane;
        const float h0 = hb[e] / dn, h1 = hb[e + 1] / dn; const float ss = wsum(h0 * h0 + h1 * h1), rstd = 1.0f / sqrtf(ss * (1.0f / 128.0f) + 1e-6f);
        const unsigned ow = *(const unsigned*)(P + 1536 + h * 128 + e); const float* gh = p.in[12] + h * 128 + e;
        *(unsigned*)(MIX + h * 128 + e) = cvt_pk_bf16(h0 * rstd * gh[0] * bflo(ow), h1 * rstd * gh[1] * bfhi(ow));
    } else if (wid == 1) {
        const int e = 2 * lane; const unsigned vw = *(const unsigned*)(P + 2560 + h * 128 + e), uw = *(const unsigned*)(P + 2048 + h * 128 + e);
        const float x0 = bflo(vw), x1 = bfhi(vw); const float mean = wsum(x0 + x1) * (1.0f / 128.0f); const float d0 = x0 - mean, d1 = x1 - mean;
        const float var = wsum(d0 * d0 + d1 * d1) * (1.0f / 128.0f), rstd = 1.0f / sqrtf(var + 1e-6f);
        const float* lg = p.in[13] + h * 128 + e; const float* lb = p.in[14] + h * 128 + e;
        const float y0 = d0 * rstd * lg[0] + lb[0], y1 = d1 * rstd * lg[1] + lb[1];
        float* vo = p.out + O_VS + (size_t)(bs * 4 + h) * 128 + e; vo[0] = y0; vo[1] = y1;
        const float w00 = p.in[15][h * 16384], bs0 = p.in[16][h * 128];
        *(unsigned*)(MIX + 512 + h * 128 + e) = cvt_pk_bf16(bflo(uw) * (w00 * y0 + bs0), bfhi(uw) * (w00 * y1 + bs0));
    }
    __syncthreads();
}

__device__ void mlstm_scan(const Params& p) {
    const float* BC = (const float*)(p.ws + WS_BC); const float* PC = (const float*)(p.ws + WS_PC); const float* CL = (const float*)(p.ws + WS_H);
    bf16_t* CST = (bf16_t*)(p.ws + WS_ADA_CST); const float* NL = (const float*)(p.ws + WS_NLOC); float* NST = (float*)(p.ws + WS_NST); float* MST = (float*)(p.ws + WS_MST);
    for (int idx = blockIdx.x * 512 + threadIdx.x; idx < 32 * 4096; idx += gridDim.x * 512) {
        const int bh = idx >> 12, e4 = idx & 4095; float m = 0.f; f32x4 ca = {0.f, 0.f, 0.f, 0.f}, na = {0.f, 0.f, 0.f, 0.f};
        for (int c = 0; c < 16; ++c) { const int item = bh * 16 + c; const float P = PC[item], B = BC[item], mx = fmaxf(m, P), al = fexp(m - mx), be = fexp(P - mx);
            u32x2 w; w.x = cvt_pk_bf16(ca[0], ca[1]); w.y = cvt_pk_bf16(ca[2], ca[3]); *(u32x2*)(CST + (size_t)item * 16384 + e4 * 4) = w;
            const f32x4 cl = *(const f32x4*)(CL + (size_t)item * 16384 + e4 * 4); ca = al * ca + be * cl;
            if (e4 < 32) { *(f32x4*)(NST + item * 128 + e4 * 4) = na; const f32x4 nl = *(const f32x4*)(NL + item * 128 + e4 * 4); na = al * na + be * nl; }
            if (e4 == 0) MST[item] = m;
            m = B + mx; }
        *(f32x4*)(p.out + O_CP + (size_t)bh * 16384 + e4 * 4) = ca;
        if (e4 < 32) *(f32x4*)(p.out + O_NP + bh * 128 + e4 * 4) = na;
        if (e4 == 0) p.out[O_MP + bh] = m;
    }
}

__device__ void cmlp_item(const Params& p, lds_u8* L, int item) {
    const int tid = threadIdx.x, wid = tid >> 6, lane = tid & 63, fr = lane & 15, fq = lane >> 4;
    const int h = item & 3, bc = item >> 2, row0 = bc * 128;
    const bf16_t* P = (const bf16_t*)(p.ws + WS_PROJ) + (size_t)row0 * NP; bf16_t* MIX = (bf16_t*)(p.ws + WS_MIX) + (size_t)row0 * D;
    LAS float* mean_s = SMF; LAS float* rstd_s = SMF + 128; LAS float* lg_s = SMF + 256; LAS float* lb_s = SMF + 384;
    { const int s = tid >> 2, q4 = tid & 3; float x[32]; float sm = 0.f;
#pragma unroll
        for (int g = 0; g < 4; ++g) { const u32x4 w = *(const u32x4*)(P + (size_t)s * NP + 2560 + h * 128 + 32 * q4 + 8 * g);
#pragma unroll
            for (int i = 0; i < 4; ++i) { x[8 * g + 2 * i] = bflo(w[i]); x[8 * g + 2 * i + 1] = bfhi(w[i]); sm += x[8 * g + 2 * i] + x[8 * g + 2 * i + 1]; } }
        sm += __shfl_xor(sm, 1); sm += __shfl_xor(sm, 2); const float mean = sm * (1.0f / 128.0f); float vq = 0.f;
#pragma unroll
        for (int i = 0; i < 32; ++i) { const float d = x[i] - mean; vq += d * d; }
        vq += __shfl_xor(vq, 1); vq += __shfl_xor(vq, 2);
        if (q4 == 0) { mean_s[s] = mean; rstd_s[s] = 1.0f / sqrtf(vq * (1.0f / 128.0f) + 1e-6f); }
        if (tid < 128) { lg_s[tid] = p.in[13][h * 128 + tid]; lb_s[tid] = p.in[14][h * 128 + tid]; } }
    { const float* W = p.in[15] + (size_t)h * 16384;
#pragma unroll
        for (int i = 0; i < 4; ++i) { const int g = tid + 512 * i, n = g >> 4, k8 = g & 15; const f32x4 a = *(const f32x4*)(W + n * 128 + 8 * k8), b = *(const f32x4*)(W + n * 128 + 8 * k8 + 4);
            float v[8] = {a[0], a[1], a[2], a[3], b[0], b[1], b[2], b[3]};
#pragma unroll
            for (int j = 0; j < 8; ++j) if (8 * k8 + j > n) v[j] = 0.f;
            u32x4 w; w.x = cvt_pk_bf16(v[0], v[1]); w.y = cvt_pk_bf16(v[2], v[3]); w.z = cvt_pk_bf16(v[4], v[5]); w.w = cvt_pk_bf16(v[6], v[7]);
            *(LAS u32x4*)(T_(0) + t128(n, k8)) = w; } }
    __syncthreads();
    stage_T(T_(2), P + 2560 + h * 128, NP, [&](int s, int e, float v) { return (v - mean_s[s]) * rstd_s[s] * lg_s[e] + lb_s[e]; });
    __syncthreads();
    f32x4 acc[8];
#pragma unroll
    for (int n = 0; n < 8; ++n) acc[n] = (f32x4){0.f, 0.f, 0.f, 0.f};
    mm16(acc, T_(0), 16 * wid, T_(2), fr, fq);
    const int t = 16 * wid + fr; const float bsv = p.in[16][h * 128 + t];
#pragma unroll
    for (int n = 0; n < 8; ++n) { const int e = 16 * n + 4 * fq; const u32x2 uw = *(const u32x2*)(P + (size_t)t * NP + 2048 + h * 128 + e);
        u32x2 o; o.x = cvt_pk_bf16(bflo(uw.x) * (acc[n][0] + bsv), bfhi(uw.x) * (acc[n][1] + bsv)); o.y = cvt_pk_bf16(bflo(uw.y) * (acc[n][2] + bsv), bfhi(uw.y) * (acc[n][3] + bsv));
        *(u32x2*)(MIX + (size_t)t * D + 512 + h * 128 + e) = o; }
    __syncthreads();
}

__device__ void mlstm_pass3(const Params& p, lds_u8* L, int item) {
    const int tid = threadIdx.x, wid = tid >> 6, lane = tid & 63, fr = lane & 15, fq = lane >> 4;
    const int bh = item >> 4, c = item & 15, b = bh >> 2, h = bh & 3, row0 = b * 2048 + c * 128;
    const bf16_t* P = (const bf16_t*)(p.ws + WS_PROJ) + (size_t)row0 * NP; bf16_t* MIX = (bf16_t*)(p.ws + WS_MIX) + (size_t)row0 * D;
    LAS float* bv = SMF; LAS float* av = SMF + 128; LAS float* pm = SMF + 256; LAS float* ns = SMF + 384;
    stage_nat(T_(0), P + h * 128, NP); stage_nat(T_(1), P + 512 + h * 128, NP);
    stage_T(T_(2), P + 1024 + h * 128, NP, [&](int, int, float v) { return v; });
    stage_nat(T_(3), (const bf16_t*)(p.ws + WS_ADA_CST) + (size_t)item * 16384, 128);
    if (tid < 128) { bv[tid] = ((const float*)(p.ws + WS_BV))[item * 128 + tid]; av[tid] = ((const float*)(p.ws + WS_AV))[item * 128 + tid];
        pm[tid] = ((const float*)(p.ws + WS_PM))[item * 128 + tid]; ns[tid] = ((const float*)(p.ws + WS_NST))[item * 128 + tid]; }
    const float mc = ((const float*)(p.ws + WS_MST))[item];
    __syncthreads();
    const int t = 16 * wid + fr;
    f32x4 acc[8], acc2[8];
#pragma unroll
    for (int n = 0; n < 8; ++n) acc[n] = (f32x4){0.f, 0.f, 0.f, 0.f};
    mm16(acc, T_(0), 16 * wid, T_(1), fr, fq);
    float qn = 0.f;
#pragma unroll
    for (int g = 0; g < 4; ++g) { const u32x4 w = *(const LAS u32x4*)(T_(0) + t128(t, 4 * g + fq)); const int d0 = 8 * (4 * g + fq);
#pragma unroll
        for (int i = 0; i < 4; ++i) qn += bflo(w[i]) * ns[d0 + 2 * i] + bfhi(w[i]) * ns[d0 + 2 * i + 1]; }
    qn += __shfl_xor(qn, 16); qn += __shfl_xor(qn, 32);
    const float Mt = fmaxf(mc, pm[t]); float rs = 0.f;
    __syncthreads();
#pragma unroll
    for (int n = 0; n < 8; ++n) { const int s0 = 16 * n + 4 * fq; f32x4 sp;
#pragma unroll
        for (int j = 0; j < 4; ++j) { const int s = s0 + j; sp[j] = (s <= t) ? acc[n][j] * fexp(av[s] - Mt) : 0.f; rs += sp[j]; }
        u32x2 o; o.x = cvt_pk_bf16(sp[0], sp[1]); o.y = cvt_pk_bf16(sp[2], sp[3]);
        *(LAS u32x2*)(T_(1) + t * 256 + ((((s0 >> 3)) ^ ((t ^ (t >> 3)) & 15)) << 4) + (s0 & 7) * 2) = o; }
    rs += __shfl_xor(rs, 16); rs += __shfl_xor(rs, 32);
    const float winter = fexp(mc - Mt), den = rs + winter * qn, mtt = bv[t] + Mt, dn = fmaxf(fabsf(den), fexp(-mtt)), rdn = 1.0f / dn;
#pragma unroll
    for (int n = 0; n < 8; ++n) acc2[n] = (f32x4){0.f, 0.f, 0.f, 0.f};
    mm16(acc2, T_(0), 16 * wid, T_(3), fr, fq);
#pragma unroll
    for (int n = 0; n < 8; ++n) acc2[n] *= winter;
    asm volatile("s_waitcnt lgkmcnt(0)" ::: "memory"); __builtin_amdgcn_wave_barrier();
    mm16(acc2, T_(1), 16 * wid, T_(2), fr, fq);
    float ss = 0.f;
#pragma unroll
    for (int n = 0; n < 8; ++n) { acc2[n] *= rdn; ss += acc2[n][0] * acc2[n][0] + acc2[n][1] * acc2[n][1] + acc2[n][2] * acc2[n][2] + acc2[n][3] * acc2[n][3]; }
    ss += __shfl_xor(ss, 16); ss += __shfl_xor(ss, 32);
    const float rstd = 1.0f / sqrtf(ss * (1.0f / 128.0f) + 1e-6f);
#pragma unroll
    for (int n = 0; n < 8; ++n) { const int e = 16 * n + 4 * fq; const u32x2 ow = *(const u32x2*)(P + (size_t)t * NP + 1536 + h * 128 + e); const f32x4 gh = *(const f32x4*)(p.in[12] + h * 128 + e);
        u32x2 o; o.x = cvt_pk_bf16(acc2[n][0] * rstd * gh[0] * bflo(ow.x), acc2[n][1] * rstd * gh[1] * bfhi(ow.x)); o.y = cvt_pk_bf16(acc2[n][2] * rstd * gh[2] * bflo(ow.y), acc2[n][3] * rstd * gh[3] * bfhi(ow.y));
        *(u32x2*)(MIX + (size_t)t * D + h * 128 + e) = o; }
    __syncthreads();
}
#ifndef MULTI_LAUNCH
#define MULTI_LAUNCH 0
#endif
constexpr int N_PHASES = 12;
__global__ void __launch_bounds__(512, 2) mk_fwd(Params p) {
    extern __shared__ __attribute__((aligned(16))) unsigned char lds_raw[];
    lds_u8* L = (lds_u8*)lds_raw;
    cg::grid_group grid = cg::this_grid();
    const int G = gridDim.x, bx = blockIdx.x;
    unsigned char* ws = p.ws;
    bf16_t* WinT = (bf16_t*)(ws + WS_WIN); bf16_t* WoutT = (bf16_t*)(ws + WS_WOUT); bf16_t* WguT = (bf16_t*)(ws + WS_WGU); bf16_t* WdT = (bf16_t*)(ws + WS_WD);
    bf16_t* WadaT = (bf16_t*)(ws + WS_ADA_CST); bf16_t* SC = (bf16_t*)(ws + WS_SC); float* MOD = (float*)(ws + WS_MOD);
    bf16_t* H = (bf16_t*)(ws + WS_H); bf16_t* PROJ = (bf16_t*)(ws + WS_PROJ); bf16_t* ACT = (bf16_t*)(ws + WS_PROJ); bf16_t* MIX = (bf16_t*)(ws + WS_MIX);
    LAS f32x4* red = (LAS f32x4*)(L + 131072);
#ifndef PHASE_MASK
#define PHASE_MASK 0xFFF
#endif
#define IN(k) (((PHASE_MASK >> (k)) & 1) && p.ph_lo <= (k) && (k) < p.ph_hi)
#define SEAM(k) do { if ((k) + 1 < p.ph_hi) grid.sync(); } while (0)

    if (IN(0)) { phase_convert(p, L); SEAM(0); }
    if (IN(1)) {
        for (int u = bx; u < 384; u += G)
            sgemm_unit<8, 1, false>(red, SC, WadaT, D, 0, 9, u * 16, 0, [&](int r, int c, f32x4 a, f32x4) { if (r < 136) { const int col = u * 16 + c; *(f32x4*)(MOD + (size_t)r * NMOD + col) = a + *(const f32x4*)(p.in[8] + col); } });
        SEAM(1); }
    if (IN(2)) { phase_norm<0>(p); SEAM(2); }
    if (IN(3)) {
        pg8::Gemm g{H, WinT, TP, NP, D}; pg8::StaticOrder S; S.init(TP, NP, G, bx); EpiProj E{PROJ};
        pg8::gemm_phase<EpiProj, pg8::StaticOrder>(L, g, S, E, nullptr);
        for (int u = bx; u < 192; u += G)
            sgemm_unit<8, 1, false>(red, H + (size_t)TP * D, WinT, D, 0, 8, u * 16, 0, [&](int r, int c, f32x4 a, f32x4) { E.small(TP + r, u * 16 + c, a); });
        SEAM(3); }
    if (IN(4)) { for (int it = bx; it < 1024; it += G) { if (it < 512) mlstm_pass1(p, L, it); else sample_item(p, L, it - 512); } SEAM(4); }
    if (IN(5)) { mlstm_scan(p); for (int it = bx; it < 512; it += G) cmlp_item(p, L, it); SEAM(5); }
    if (IN(6)) { for (int it = bx; it < 512; it += G) mlstm_pass3(p, L, it); SEAM(6); }
    if (IN(7)) {
        pg8::Gemm g{MIX, WoutT, TP, D, D}; pg8::StaticOrder S; S.init(TP, D, G, bx); EpiRes E{p.in[0], MOD + 2048, p.out};
        pg8::gemm_phase<EpiRes, pg8::StaticOrder>(L, g, S, E, nullptr);
        for (int u = bx; u < 256; u += G) { const int ct = u >> 2, rg = u & 3;
            sgemm_unit<2, 4, false>(red, MIX + (size_t)TP * D, WoutT, D, rg * 2, 2, ct * 16, 0, [&](int r, int c, f32x4 a, f32x4) { const int col = ct * 16 + c;
                const f32x4 xv = *(const f32x4*)(p.in[1] + (size_t)r * D + col), gt = *(const f32x4*)(MOD + (size_t)(8 + r) * NMOD + 2048 + col); *(f32x4*)(p.out + (size_t)(TP + r) * D + col) = xv + gt * a; }); }
        SEAM(7); }
    if (IN(8)) { phase_norm<1>(p); SEAM(8); }
    if (IN(9)) {
        pg8::Gemm g{H, WguT, TP, 2 * DFF, D}; pg8::StaticOrder S; S.init(TP, 2 * DFF, G, bx); EpiSwi E{ACT};
        pg8::gemm_phase<EpiSwi, pg8::StaticOrder>(L, g, S, E, nullptr);
        for (int u = bx; u < 176; u += G) { const int br = (u >> 3) * 256 + (u & 7) * 16;
            sgemm_unit<8, 1, true>(red, H + (size_t)TP * D, WguT, D, 0, 8, br, br + 128, [&](int r, int c, f32x4 a, f32x4 b) { f32x4 v;
                for (int j = 0; j < 4; ++j) v[j] = a[j] * sigm(a[j]) * b[j];
                u32x2 w; w.x = cvt_pk_bf16(v[0], v[1]); w.y = cvt_pk_bf16(v[2], v[3]); *(u32x2*)(ACT + (size_t)(TP + r) * DFF + u * 16 + c) = w; }); }
        SEAM(9); }
    if (IN(10)) {
        pg8::Gemm g{ACT, WdT, TP, D, DFF}; pg8::StaticOrder S; S.init(TP, D, G, bx); EpiRes E{p.out, MOD + 5120, p.out};
        pg8::gemm_phase<EpiRes, pg8::StaticOrder>(L, g, S, E, nullptr);
        for (int u = bx; u < 256; u += G) { const int ct = u >> 2, rg = u & 3;
            sgemm_unit<2, 4, false>(red, ACT + (size_t)TP * DFF, WdT, DFF, rg * 2, 2, ct * 16, 0, [&](int r, int c, f32x4 a, f32x4) { const int col = ct * 16 + c;
                float* op = p.out + (size_t)(TP + r) * D + col; const f32x4 gt = *(const f32x4*)(MOD + (size_t)(8 + r) * NMOD + 5120 + col); *(f32x4*)op = *(const f32x4*)op + gt * a; }); }
        SEAM(10); }
    if (IN(11)) { phase_norm<2>(p); }
}

extern "C" void kernel_launch(void* const* d_in, const int* in_sizes, int n_in, void* d_out, int out_size, void* d_ws, size_t ws_size, hipStream_t stream) {
    static int grid = 0;
    if (grid == 0) {
        int dev = 0, cus = 0, per_cu = 0;
        hipGetDevice(&dev); hipDeviceGetAttribute(&cus, hipDeviceAttributeMultiprocessorCount, dev);
        if (hipFuncSetAttribute((const void*)mk_fwd, hipFuncAttributeMaxDynamicSharedMemorySize, LDS_BYTES) != hipSuccess) { fprintf(stderr, "kernel_launch: hipFuncSetAttribute failed\n"); grid = -1; return; }
        if (hipOccupancyMaxActiveBlocksPerMultiprocessor(&per_cu, (const void*)mk_fwd, 512, LDS_BYTES) != hipSuccess || per_cu < 1) { fprintf(stderr, "kernel_launch: occupancy query says %d\n", per_cu); per_cu = 1; }
        (void)hipGetLastError();
        grid = cus * per_cu;
        if (n_in != 22 || ws_size < WS_END) { fprintf(stderr, "kernel_launch: unexpected n_in %d / ws %zu\n", n_in, ws_size); grid = -1; return; }
    }
    if (grid < 0) return;
    Params p{};
    for (int i = 0; i < 22; ++i) p.in[i] = (const float*)d_in[i];
    p.out = (float*)d_out; p.ws = (unsigned char*)d_ws;
#if MULTI_LAUNCH
    for (int ph = 0; ph < N_PHASES; ++ph) { p.ph_lo = ph; p.ph_hi = ph + 1; hipLaunchKernelGGL(mk_fwd, dim3(grid), dim3(512), LDS_BYTES, stream, p); }
#else
    p.ph_lo = 0; p.ph_hi = N_PHASES;
    void* args[] = {&p};
    hipError_t e = hipLaunchCooperativeKernel((const void*)mk_fwd, dim3(grid), dim3(512), args, LDS_BYTES, stream);
    if (e != hipSuccess) fprintf(stderr, "kernel_launch: cooperative launch failed: %s (grid %d)\n", hipGetErrorString(e), grid);
#endif
}
```

```cpp
#include <hip/hip_cooperative_groups.h>
#include <cstdio>
#include <hip/hip_runtime.h>
namespace pg8 {
#define PG8_LAS __attribute__((address_space(3)))
typedef unsigned short bf16_t;
typedef short bf16x8 __attribute__((ext_vector_type(8)));
typedef float f32x4 __attribute__((ext_vector_type(4)));
typedef unsigned u32x4 __attribute__((ext_vector_type(4)));
constexpr int BM = 256, BK = 64, HALF = 128, HTB = HALF * BK * 2  , STAGE_BYTES = 8 * HTB, NXCD = 8, WGM = 8;

__host__ __device__ __forceinline__ int lds_byte(int r, int c) { const int st = (r >> 4) * 2 + (c >> 5), rr = r & 15, cc = c & 31, ob = rr * 64 + cc * 2; return st * 1024 + (ob ^ (((ob >> 9) & 1) << 5)); }
__host__ __device__ __forceinline__ void stage_rc(int b, int& R, int& C) { const int st = b / 1024, sb = b % 1024, swz = sb ^ (((sb >> 9) & 1) << 5); R = (st >> 1) * 16 + swz / 64; C = (st & 1) * 32 + (swz % 64) / 2; }
__host__ __device__ __forceinline__ int perm32(int rho) { const int n = rho >> 4, i = rho & 15; return 8 * (i >> 2) + 4 * n + (i & 3); }

struct Unit { int pm, pn; };
struct Gemm { const bf16_t* A; const bf16_t* Bt; int M, N, K; };

struct StaticOrder {
    int nM, nN, nwg, G, c;
    __host__ __device__ void init(int M, int N, int G_, int c_) { nM = M / BM; nN = N / BM; nwg = nM * nN; G = G_; c = c_; }
    __host__ __device__ bool next(int i, Unit& u) const {
        const long L = (long)i * G + c; if (L >= nwg) return false;
        int wgid = (int)L; { const int q = nwg / NXCD, r = nwg % NXCD, xcd = wgid % NXCD, off = wgid / NXCD; wgid = (xcd < r ? xcd * (q + 1) : r * (q + 1) + (xcd - r) * q) + off; }
        const int nig = WGM * nN, gid = wgid / nig, fm = gid * WGM, gsz = (nM - fm) < WGM ? (nM - fm) : WGM;
        u.pm = fm + ((wgid % nig) % gsz); u.pn = (wgid % nig) / gsz; return true;
    }
    __device__ __forceinline__ void a_ready(const Unit&) const {}
    __device__ __forceinline__ void done(const Unit&) const {}
};
struct CountedOrder : StaticOrder {
    const unsigned* ready; unsigned need; unsigned* tmo;
    __device__ __forceinline__ void a_ready(const Unit& u) const {
        if (threadIdx.x < 64) {
            const unsigned long long t0 = __builtin_amdgcn_s_memrealtime(); unsigned polls = 0;
            while ((unsigned)__builtin_amdgcn_readfirstlane(__hip_atomic_load(ready + 64 * u.pm, __ATOMIC_RELAXED, __HIP_MEMORY_SCOPE_AGENT)) < need) {
                if ((++polls & 255u) == 0u && __builtin_amdgcn_readfirstlane(__hip_atomic_load(tmo, __ATOMIC_RELAXED, __HIP_MEMORY_SCOPE_AGENT)) != 0u) break;
                if (__builtin_amdgcn_s_memrealtime() - t0 > 2000000ull) {
                    if (threadIdx.x == 0) { unsigned expect = 0u; __hip_atomic_compare_exchange_strong(tmo + 1, &expect, 0x600u | (unsigned)(u.pm & 0xff), __ATOMIC_RELAXED, __ATOMIC_RELAXED, __HIP_MEMORY_SCOPE_AGENT); __hip_atomic_store(tmo, 1u, __ATOMIC_RELAXED, __HIP_MEMORY_SCOPE_AGENT); }
                    break; }
                __builtin_amdgcn_s_sleep(2); }
            __builtin_amdgcn_fence(__ATOMIC_ACQUIRE, "agent");
            asm volatile("s_waitcnt vmcnt(0)" ::: "memory");
        }
#if !defined(BROKEN_HOOK_NO_BARRIER)
        asm volatile("" ::: "memory"); __builtin_amdgcn_s_barrier(); asm volatile("" ::: "memory");
#endif
    }
};

template <class Epi, class Sched, bool STAMP = false>
__device__ __forceinline__ void gemm_phase(PG8_LAS unsigned char* lds, const Gemm g, const Sched& S, const Epi& E, unsigned long long* stamps) {
    const int tid = threadIdx.x, wid = __builtin_amdgcn_readfirstlane(tid >> 6), lane = tid & 63, wr = wid >> 2, wc = wid & 3, fr = lane & 15, fq = lane >> 4;
    const int K = g.K, nt = K / BK;
    int ts_lo = 0, ts_hi = 0, nts = 0; const unsigned long long rt_entry = STAMP ? (unsigned long long)wall_clock64() : 0ull;
#define PG8_STAMP() do { if (STAMP && wid == 0 && nts < 64) { const unsigned long long _c = (unsigned long long)clock64(); \
        ts_lo = (lane == nts) ? (int)(unsigned)_c : ts_lo; ts_hi = (lane == nts) ? (int)(unsigned)(_c >> 32) : ts_hi; ++nts; } } while (0)
    PG8_STAMP();
    unsigned voffA[2], voffB[2];
#pragma unroll
    for (int i = 0; i < 2; ++i) { int R, C; stage_rc(tid * 16 + i * 8192, R, C); const int Rb = Epi::PERM ? ((R & ~31) + perm32(R & 31)) : R;
        voffA[i] = (unsigned)(R * K + C) * 2u; voffB[i] = (unsigned)(Rb * K + C) * 2u; }
    const size_t kstep = (size_t)(BK * 2);
    const size_t hstep = (size_t)HALF * K * 2;
    const size_t tstep = 2 * hstep;
    const unsigned ldsw = (unsigned)wid * 1024u;
    const int aoff = lds_byte(wr * 64 + fr, fq * 8), boff = lds_byte(wc * 32 + fr, fq * 8);
#define PG8_SA(b, h) (((b) * 2 + (h)) * HTB)
#define PG8_SB(b, h) ((4 + (b) * 2 + (h)) * HTB)
#define PG8_STAGE(bufoff, gbase, voff) do { _Pragma("unroll") for (int _i = 0; _i < 2; ++_i) \
        __builtin_amdgcn_global_load_lds((const unsigned*)((const char*)(gbase) + (voff)[_i]), (PG8_LAS unsigned*)(lds + (bufoff) + ldsw + _i * 8192), 16, 0, 0); } while (0)
#define PG8_LDA(dst, b, h) do { _Pragma("unroll") for (int m = 0; m < 4; ++m) _Pragma("unroll") for (int k = 0; k < 2; ++k) dst[m][k] = *(const PG8_LAS bf16x8*)(lds + PG8_SA(b, h) + aoff + m * 2048 + k * 1024); } while (0)
#define PG8_LDB(dst, b, h) do { _Pragma("unroll") for (int n = 0; n < 2; ++n) _Pragma("unroll") for (int k = 0; k < 2; ++k) dst[n][k] = *(const PG8_LAS bf16x8*)(lds + PG8_SB(b, h) + boff + n * 2048 + k * 1024); } while (0)
#define PG8_MMA(ai, bj, At, Bt) do { __builtin_amdgcn_s_setprio(1); _Pragma("unroll") for (int m = 0; m < 4; ++m) _Pragma("unroll") for (int n = 0; n < 2; ++n) _Pragma("unroll") for (int k = 0; k < 2; ++k) \
        acc[ai][bj][m][n] = __builtin_amdgcn_mfma_f32_16x16x32_bf16(Bt[n][k], At[m][k], acc[ai][bj][m][n], 0, 0, 0); __builtin_amdgcn_s_setprio(0); } while (0)
#define PG8_WAIT_V(n) asm volatile("s_waitcnt vmcnt(" #n ")" ::: "memory")
#define PG8_WAIT_L(n) asm volatile("s_waitcnt lgkmcnt(" #n ")" ::: "memory")
#define PG8_BAR __builtin_amdgcn_s_barrier()
#define PG8_SCHED __builtin_amdgcn_sched_barrier(0)
    Unit cur, nxt; int ui = 0;
    if (!S.next(0, cur)) return;
    f32x4 acc[2][2][4][2];
#pragma unroll
    for (int a = 0; a < 2; ++a)
#pragma unroll
        for (int b = 0; b < 2; ++b)
#pragma unroll
            for (int m = 0; m < 4; ++m)
#pragma unroll
                for (int n = 0; n < 2; ++n) acc[a][b][m][n] = (f32x4){0.f, 0.f, 0.f, 0.f};
    bf16x8 At[4][2], B0[2][2], B1[2][2];
    const char* cA = (const char*)g.A + (size_t)cur.pm * tstep; const char* cB = (const char*)g.Bt + (size_t)cur.pn * tstep;
    S.a_ready(cur);
    PG8_STAGE(PG8_SB(0, 0), cB, voffB); PG8_STAGE(PG8_SA(0, 0), cA, voffA); PG8_STAGE(PG8_SB(0, 1), cB + hstep, voffB); PG8_STAGE(PG8_SA(0, 1), cA + hstep, voffA);
    if (wr == 1) PG8_BAR;
    PG8_WAIT_V(4); PG8_BAR;
    PG8_STAGE(PG8_SB(1, 0), cB + kstep, voffB); PG8_STAGE(PG8_SA(1, 0), cA + kstep, voffA); PG8_STAGE(PG8_SB(1, 1), cB + hstep + kstep, voffB);
    PG8_WAIT_V(6); PG8_BAR;
    PG8_STAMP();
    for (;;) {
        const bool has_next = S.next(ui + 1, nxt);
        const char* nA = has_next ? (const char*)g.A + (size_t)nxt.pm * tstep : cA; const char* nB = has_next ? (const char*)g.Bt + (size_t)nxt.pn * tstep : cB;
        for (int t = 0; t < nt; t += 2) {
            const bool last = (t == nt - 2);
            const char* a1 = cA + (size_t)(t + 1) * kstep;
            const char* a2 = last ? nA : cA + (size_t)(t + 2) * kstep; const char* b2 = last ? nB : cB + (size_t)(t + 2) * kstep;
            const char* a3 = a2 + kstep; const char* b3 = b2 + kstep;
            if (last && has_next) S.a_ready(nxt);
            PG8_LDB(B0, 0, 0); PG8_SCHED; PG8_LDA(At, 0, 0); PG8_STAGE(PG8_SA(1, 1), a1 + hstep, voffA);
            PG8_WAIT_L(8); PG8_BAR; PG8_WAIT_L(0); PG8_MMA(0, 0, At, B0); PG8_BAR; PG8_SCHED;
            PG8_LDB(B1, 0, 1); PG8_STAGE(PG8_SB(0, 0), b2, voffB);
            PG8_BAR; PG8_WAIT_L(0); PG8_MMA(0, 1, At, B1); PG8_BAR;
            PG8_LDA(At, 0, 1); PG8_STAGE(PG8_SA(0, 0), a2, voffA);
            PG8_BAR; PG8_WAIT_L(0); PG8_MMA(1, 0, At, B0); PG8_BAR; PG8_SCHED;
            PG8_STAGE(PG8_SB(0, 1), b2 + hstep, voffB);
            PG8_WAIT_V(6); PG8_BAR; PG8_MMA(1, 1, At, B1); PG8_BAR;
            PG8_LDB(B0, 1, 0); PG8_SCHED; PG8_LDA(At, 1, 0); PG8_STAGE(PG8_SA(0, 1), a2 + hstep, voffA);
            PG8_WAIT_L(8); PG8_BAR; PG8_WAIT_L(0); PG8_MMA(0, 0, At, B0); PG8_BAR; PG8_SCHED;
            PG8_LDB(B1, 1, 1); PG8_STAGE(PG8_SB(1, 0), b3, voffB);
            PG8_BAR; PG8_WAIT_L(0); PG8_MMA(0, 1, At, B1); PG8_BAR;
            PG8_LDA(At, 1, 1); PG8_STAGE(PG8_SA(1, 0), a3, voffA);
            PG8_BAR; PG8_WAIT_L(0); PG8_MMA(1, 0, At, B0); PG8_BAR; PG8_SCHED;
            PG8_STAGE(PG8_SB(1, 1), b3 + hstep, voffB);
            PG8_WAIT_V(6); PG8_BAR; PG8_MMA(1, 1, At, B1); PG8_BAR;
        }
        PG8_STAMP();
        if constexpr (!Epi::AFTER_DRAIN) { E(acc, cur, wr, wc, fr, fq); S.done(cur); }
        PG8_STAMP();
        if (!has_next) break;
#pragma unroll
        for (int a = 0; a < 2; ++a)
#pragma unroll
            for (int b = 0; b < 2; ++b)
#pragma unroll
                for (int m = 0; m < 4; ++m)
#pragma unroll
                    for (int n = 0; n < 2; ++n) acc[a][b][m][n] = (f32x4){0.f, 0.f, 0.f, 0.f};
        cur = nxt; cA = nA; cB = nB; ++ui;
    }
    PG8_WAIT_V(0);
    if (wr == 0) PG8_BAR;
    PG8_BAR;
    if constexpr (Epi::AFTER_DRAIN) { E.fused(acc, cur, wr, wc, fr, fq, lds, wid, lane); S.done(cur); }
    PG8_STAMP();
    if (STAMP && wid == 0) { stamps[lane] = lane < nts ? (((unsigned long long)(unsigned)ts_hi << 32) | (unsigned)ts_lo) : 0ull;
        if (lane == 62) stamps[62] = rt_entry; if (lane == 63) stamps[63] = (unsigned long long)wall_clock64(); }
#undef PG8_STAMP
#undef PG8_SA
#undef PG8_SB
#undef PG8_STAGE
#undef PG8_LDA
#undef PG8_LDB
#undef PG8_MMA
#undef PG8_WAIT_V
#undef PG8_WAIT_L
#undef PG8_BAR
#undef PG8_SCHED
}
}
namespace cg = cooperative_groups;
using pg8::Unit;
#define LAS __attribute__((address_space(3)))
typedef LAS unsigned char lds_u8;
typedef unsigned short bf16_t;
typedef short bf16x8 __attribute__((ext_vector_type(8)));
typedef float f32x4 __attribute__((ext_vector_type(4)));
typedef unsigned u32x4 __attribute__((ext_vector_type(4)));
typedef unsigned u32x2 __attribute__((ext_vector_type(2)));

constexpr int D = 1024, TP = 16384, TS = 128, ROWS = TP + TS, NIN = 3080, NP = 3072, DFF = 2816, NMOD = 6144;
constexpr float LOG2E = 1.4426950408889634f;
constexpr int LDS_BYTES = 131072 + 8192 + 64;
constexpr size_t WS_WIN = 0, WS_WOUT = 6291456, WS_WGU = 8388608, WS_WD = 19922944, WS_ADA_CST = 25690112, WS_SC = 42467328,
    WS_MOD = 42762240, WS_GATES = 46104576, WS_H = 46632960, WS_PROJ = 80711680, WS_MIX = 182947840, WS_VEC = 217026560;
constexpr size_t WS_BV = WS_VEC, WS_AV = WS_VEC + 262144, WS_PM = WS_VEC + 2 * 262144, WS_NLOC = WS_VEC + 3 * 262144, WS_NST = WS_VEC + 4 * 262144,
    WS_BC = WS_VEC + 5 * 262144, WS_PC = WS_BC + 2048, WS_MST = WS_PC + 2048, WS_BAR = WS_MST + 2048, WS_END = WS_BAR + 16384;
constexpr size_t O_Y = 0, O_CP = 16908288, O_NP = 17432576, O_MP = 17436672, O_CS = 17436704, O_NS = 25825312, O_MS = 25890848, O_VS = 25891360;

struct Params { const float* in[22]; float* out; unsigned char* ws; int ph_lo, ph_hi; };

__device__ __forceinline__ unsigned cvt_pk_bf16(float lo, float hi) { unsigned r; asm("v_cvt_pk_bf16_f32 %0, %1, %2" : "=v"(r) : "v"(lo), "v"(hi)); return r; }
__device__ __forceinline__ float bflo(unsigned w) { return __uint_as_float(w << 16); }
__device__ __forceinline__ float bfhi(unsigned w) { return __uint_as_float(w & 0xffff0000u); }
__device__ __forceinline__ float fexp(float x) { return __builtin_amdgcn_exp2f(x * LOG2E); }
__device__ __forceinline__ float sigm(float x) { return __builtin_amdgcn_rcpf(1.0f + fexp(-x)); }
__device__ __forceinline__ float gelu_t(float x) { return x * sigm(1.5957691216057308f * x * (1.0f + 0.044715f * x * x)); }
__device__ __forceinline__ float logsig(float f) { return fminf(f, 0.f) - log1pf(expf(-fabsf(f))); }
__device__ __forceinline__ float wsum(float v) { for (int o = 32; o >= 1; o >>= 1) v += __shfl_xor(v, o); return v; }
__device__ __forceinline__ int mod_row(int row) { return row < TP ? (row >> 11) : (8 + row - TP); }

__device__ __forceinline__ f32x4 proj_act(int seg, f32x4 v) {
    if (seg == 0) { v *= 0.08838834764831845f; }
    else if (seg == 3) { for (int j = 0; j < 4; ++j) v[j] = sigm(v[j]); }
    else if (seg >= 4) { for (int j = 0; j < 4; ++j) v[j] = gelu_t(v[j]); }
    return v;
}
struct EpiProj {
    static constexpr bool PERM = false, AFTER_DRAIN = false;
    bf16_t* P;
    __device__ __forceinline__ void operator()(const f32x4 (&acc)[2][2][4][2], const Unit& u, int wr, int wc, int fr, int fq) const {
        const int seg = u.pn >> 1; const int row0 = u.pm * 256 + wr * 64 + fr, col0 = u.pn * 256 + wc * 32 + 4 * fq;
#pragma unroll
        for (int ai = 0; ai < 2; ++ai)
#pragma unroll
            for (int m = 0; m < 4; ++m) { bf16_t* rowp = P + (size_t)(row0 + ai * 128 + m * 16) * NP + col0;
#pragma unroll
                for (int bj = 0; bj < 2; ++bj)
#pragma unroll
                    for (int n = 0; n < 2; ++n) { const f32x4 v = proj_act(seg, acc[ai][bj][m][n]); u32x2 w; w.x = cvt_pk_bf16(v[0], v[1]); w.y = cvt_pk_bf16(v[2], v[3]);
                        *(u32x2*)(rowp + bj * 128 + n * 16) = w; } }
    }
    __device__ __forceinline__ void small(int row, int col, f32x4 v) const { v = proj_act(col >> 9, v); u32x2 w; w.x = cvt_pk_bf16(v[0], v[1]); w.y = cvt_pk_bf16(v[2], v[3]); *(u32x2*)(P + (size_t)row * NP + col) = w; }
};
struct EpiRes {
    static constexpr bool PERM = false, AFTER_DRAIN = false;
    const float* x; const float* gate; float* o;
    __device__ __forceinline__ void operator()(const f32x4 (&acc)[2][2][4][2], const Unit& u, int wr, int wc, int fr, int fq) const {
        const int row0 = u.pm * 256 + wr * 64 + fr, col0 = u.pn * 256 + wc * 32 + 4 * fq; const float* gp = gate + (size_t)(u.pm >> 3) * NMOD + col0;
        f32x4 g[2][2];
#pragma unroll
        for (int bj = 0; bj < 2; ++bj)
#pragma unroll
            for (int n = 0; n < 2; ++n) g[bj][n] = *(const f32x4*)(gp + bj * 128 + n * 16);
#pragma unroll
        for (int ai = 0; ai < 2; ++ai)
#pragma unroll
            for (int m = 0; m < 4; ++m) { const size_t off = (size_t)(row0 + ai * 128 + m * 16) * D + col0;
#pragma unroll
                for (int bj = 0; bj < 2; ++bj)
#pragma unroll
                    for (int n = 0; n < 2; ++n) { const f32x4 xv = *(const f32x4*)(x + off + bj * 128 + n * 16); *(f32x4*)(o + off + bj * 128 + n * 16) = xv + g[bj][n] * acc[ai][bj][m][n]; }
                asm volatile("" ::: "memory"); }
    }
};
struct EpiSwi {
    static constexpr bool PERM = false, AFTER_DRAIN = false;
    bf16_t* A;
    __device__ __forceinline__ void operator()(const f32x4 (&acc)[2][2][4][2], const Unit& u, int wr, int wc, int fr, int fq) const {
        const int row0 = u.pm * 256 + wr * 64 + fr, col0 = u.pn * 128 + wc * 32 + 4 * fq;
#pragma unroll
        for (int ai = 0; ai < 2; ++ai)
#pragma unroll
            for (int m = 0; m < 4; ++m) { bf16_t* rowp = A + (size_t)(row0 + ai * 128 + m * 16) * DFF + col0;
#pragma unroll
                for (int n = 0; n < 2; ++n) { const f32x4 a = acc[ai][0][m][n], b = acc[ai][1][m][n]; f32x4 r;
#pragma unroll
                    for (int j = 0; j < 4; ++j) r[j] = a[j] * sigm(a[j]) * b[j];
                    u32x2 w; w.x = cvt_pk_bf16(r[0], r[1]); w.y = cvt_pk_bf16(r[2], r[3]); *(u32x2*)(rowp + n * 16) = w; } }
    }
};

template <int RT, int KS, bool DUAL, class F>
__device__ __forceinline__ void sgemm_unit(LAS f32x4* red, const bf16_t* A, const bf16_t* Bt, int K, int rt0, int nrt, int brow0, int brow_dual, const F& f) {
    const int tid = threadIdx.x, wid = tid >> 6, lane = tid & 63, fr = lane & 15, fq = lane >> 4, rtl = wid % RT, ks = wid / RT;
    const int kb = ks * (K / KS), ke = kb + K / KS;
    for (int rt = rt0 + rtl; rt < rt0 + nrt; rt += RT) {
        f32x4 acc = {0.f, 0.f, 0.f, 0.f}, acc2 = {0.f, 0.f, 0.f, 0.f};
        const bf16_t* ap = A + (size_t)(rt * 16 + fr) * K + fq * 8; const bf16_t* bp = Bt + (size_t)(brow0 + fr) * K + fq * 8; const bf16_t* bp2 = Bt + (size_t)(brow_dual + fr) * K + fq * 8;
#pragma unroll 4
        for (int k = kb; k < ke; k += 32) {
            const bf16x8 a = *(const bf16x8*)(ap + k), b = *(const bf16x8*)(bp + k);
            acc = __builtin_amdgcn_mfma_f32_16x16x32_bf16(b, a, acc, 0, 0, 0);
            if (DUAL) { const bf16x8 b2 = *(const bf16x8*)(bp2 + k); acc2 = __builtin_amdgcn_mfma_f32_16x16x32_bf16(b2, a, acc2, 0, 0, 0); }
        }
        if (KS > 1) {
            red[wid * 64 + lane] = acc; __syncthreads();
            if (ks == 0) { for (int s = 1; s < KS; ++s) acc += red[(rtl + RT * s) * 64 + lane]; }
            __syncthreads();
            if (ks != 0) continue;
        }
        f(rt * 16 + fr, 4 * fq, acc, acc2);
    }
}
__device__ __forceinline__ void conv_unit(LAS float* T, const float* src, int ld_src, int k0, int c0, bf16_t* dst, int ldd, int n0) {
    const int tid = threadIdx.x; const int l16 = tid & 15, kr = tid >> 4;
#pragma unroll
    for (int ps = 0; ps < 2; ++ps) { const int kk = kr + 32 * ps; const f32x4 v = *(const f32x4*)(src + (size_t)(k0 + kk) * ld_src + c0 + 4 * l16);
#pragma unroll
        for (int i = 0; i < 4; ++i) T[kk * 65 + 4 * l16 + i] = v[i]; }
    __syncthreads();
    const int kg = tid & 7, n = tid >> 3; float v[8];
#pragma unroll
    for (int i = 0; i < 8; ++i) v[i] = T[(8 * kg + i) * 65 + n];
    u32x4 w; w.x = cvt_pk_bf16(v[0], v[1]); w.y = cvt_pk_bf16(v[2], v[3]); w.z = cvt_pk_bf16(v[4], v[5]); w.w = cvt_pk_bf16(v[6], v[7]);
    *(u32x4*)(dst + (size_t)(n0 + n) * ldd + k0 + 8 * kg) = w;
    __syncthreads();
}
__device__ void phase_convert(const Params& p, lds_u8* L) {
    LAS float* T = (LAS float*)L; unsigned char* ws = p.ws;
    const int NU = 4672 + 72;
    for (int u = blockIdx.x; u < NU; u += gridDim.x) {
        if (u < 768) { const int kb = u / 48, nb = u % 48; const int c0 = nb * 64 + (nb >= 32 ? 8 : 0); conv_unit(T, p.in[10], NIN, kb * 64, c0, (bf16_t*)(ws + WS_WIN), D, nb * 64); }
        else if (u < 1024) { const int v = u - 768, kb = v / 16, nb = v % 16; conv_unit(T, p.in[17], D, kb * 64, nb * 64, (bf16_t*)(ws + WS_WOUT), D, nb * 64); }
        else if (u < 2432) { const int v = u - 1024, kb = v / 88, nb = v % 88; const int tile = nb >> 2, q4 = nb & 3; const int c0 = (q4 < 2) ? tile * 128 + q4 * 64 : DFF + tile * 128 + (q4 - 2) * 64;
            conv_unit(T, p.in[19], 2 * DFF, kb * 64, c0, (bf16_t*)(ws + WS_WGU), D, nb * 64); }
        else if (u < 3136) { const int v = u - 2432, kb = v / 16, nb = v % 16; conv_unit(T, p.in[20], D, kb * 64, nb * 64, (bf16_t*)(ws + WS_WD), DFF, nb * 64); }
        else if (u < 4672) { const int v = u - 3136, kb = v / 96, nb = v % 96; conv_unit(T, p.in[7], NMOD, kb * 64, nb * 64, (bf16_t*)(ws + WS_ADA_CST), D, nb * 64); }
        else { const int v = u - 4672; const int idx = v * 512 + threadIdx.x;
            const int r = idx >> 8, c = (idx & 255) * 4; f32x4 x = {0.f, 0.f, 0.f, 0.f};
            if (r < 8) x = *(const f32x4*)(p.in[2] + r * D + c); else if (r < 136) x = *(const f32x4*)(p.in[3] + (r - 8) * D + c);
            u32x2 w; w.x = cvt_pk_bf16(x[0] * sigm(x[0]), x[1] * sigm(x[1])); w.y = cvt_pk_bf16(x[2] * sigm(x[2]), x[3] * sigm(x[3]));
            *(u32x2*)((bf16_t*)(ws + WS_SC) + r * D + c) = w; }
    }
}

template <int MODE> __device__ void phase_norm(const Params& p) {
    const int lane = threadIdx.x & 63, gw = blockIdx.x * 8 + (threadIdx.x >> 6), nW = gridDim.x * 8;
    const float* mod = (const float*)(p.ws + WS_MOD); bf16_t* H = (bf16_t*)(p.ws + WS_H); float* gates = (float*)(p.ws + WS_GATES);
    const float* gain = MODE == 0 ? p.in[9] : (MODE == 1 ? p.in[18] : p.in[21]);
    f32x4 gv[4];
#pragma unroll
    for (int j = 0; j < 4; ++j) gv[j] = *(const f32x4*)(gain + 4 * lane + 256 * j);
    f32x4 wg[4][4][2];
    if (MODE == 0) {
#pragma unroll
        for (int j = 0; j < 4; ++j)
#pragma unroll
            for (int i = 0; i < 4; ++i) { const float* wp = p.in[10] + (size_t)(4 * lane + 256 * j + i) * NIN + 2048; wg[j][i][0] = *(const f32x4*)wp; wg[j][i][1] = *(const f32x4*)(wp + 4); }
    }
    for (int r = gw; r < ROWS; r += nW) {
        const float* src = MODE == 0 ? (r < TP ? p.in[0] + (size_t)r * D : p.in[1] + (size_t)(r - TP) * D) : p.out + (size_t)r * D;
        f32x4 xv[4]; float ss = 0.f;
#pragma unroll
        for (int j = 0; j < 4; ++j) { xv[j] = *(const f32x4*)(src + 4 * lane + 256 * j); ss += xv[j][0] * xv[j][0] + xv[j][1] * xv[j][1] + xv[j][2] * xv[j][2] + xv[j][3] * xv[j][3]; }
        ss = wsum(ss); const float rstd = 1.0f / sqrtf(ss * (1.0f / 1024.0f) + 1e-6f);
        if (MODE == 2) {
#pragma unroll
            for (int j = 0; j < 4; ++j) *(f32x4*)(p.out + (size_t)r * D + 4 * lane + 256 * j) = xv[j] * rstd * gv[j];
        } else {
            const float* mp = mod + (size_t)mod_row(r) * NMOD + (MODE == 0 ? 0 : 3072);
            f32x4 ga = {0.f, 0.f, 0.f, 0.f}, gb = {0.f, 0.f, 0.f, 0.f};
#pragma unroll
            for (int j = 0; j < 4; ++j) { const f32x4 sh = *(const f32x4*)(mp + 4 * lane + 256 * j), sc = *(const f32x4*)(mp + 1024 + 4 * lane + 256 * j);
                const f32x4 h = xv[j] * rstd * gv[j] * (1.0f + sc) + sh;
                u32x2 w; w.x = cvt_pk_bf16(h[0], h[1]); w.y = cvt_pk_bf16(h[2], h[3]); *(u32x2*)(H + (size_t)r * D + 4 * lane + 256 * j) = w;
                if (MODE == 0) {
#pragma unroll
                    for (int i = 0; i < 4; ++i) { ga += h[i] * wg[j][i][0]; gb += h[i] * wg[j][i][1]; } } }
            if (MODE == 0) {
#pragma unroll
                for (int i = 0; i < 4; ++i) { ga[i] = wsum(ga[i]); gb[i] = wsum(gb[i]); }
                if (lane == 0) { const f32x4 b0 = *(const f32x4*)(p.in[11]), b1 = *(const f32x4*)(p.in[11] + 4); *(f32x4*)(gates + (size_t)r * 8) = ga + b0; *(f32x4*)(gates + (size_t)r * 8 + 4) = gb + b1; }
            }
        }
    }
}

__device__ __forceinline__ int t128(int n, int k8) { return n * 256 + ((k8 ^ ((n ^ (n >> 3)) & 15)) << 4); }
__device__ __forceinline__ void stage_nat(lds_u8* T, const bf16_t* src, int ld) {
#pragma unroll
    for (int i = 0; i < 4; ++i) { const int g = threadIdx.x + 512 * i, n = g >> 4, k8 = g & 15; *(LAS u32x4*)(T + t128(n, k8)) = *(const u32x4*)(src + (size_t)n * ld + k8 * 8); }
}
template <class F> __device__ __forceinline__ void stage_T(lds_u8* T, const bf16_t* src, int ld, const F& xf) {
    const int rg = threadIdx.x >> 4, cg = threadIdx.x & 15; u32x4 r[4];
#pragma unroll
    for (int j = 0; j < 4; ++j) r[j] = *(const u32x4*)(src + (size_t)(4 * rg + j) * ld + 8 * cg);
#pragma unroll
    for (int i = 0; i < 8; ++i) { float v[4];
#pragma unroll
        for (int j = 0; j < 4; ++j) { const unsigned w = r[j][i >> 1]; v[j] = xf(4 * rg + j, 8 * cg + i, (i & 1) ? bfhi(w) : bflo(w)); }
        u32x2 o; o.x = cvt_pk_bf16(v[0], v[1]); o.y = cvt_pk_bf16(v[2], v[3]);
        const int n = 8 * cg + i; *(LAS u32x2*)(T + n * 256 + ((((rg >> 1)) ^ ((n ^ (n >> 3)) & 15)) << 4) + (rg & 1) * 8) = o; }
}
__device__ __forceinline__ void mm16(f32x4 (&acc)[8], const lds_u8* A, int arow0, const lds_u8* B, int fr, int fq) {
#pragma unroll 1
    for (int ks = 0; ks < 4; ++ks) { const bf16x8 a = *(const LAS bf16x8*)(A + t128(arow0 + fr, 4 * ks + fq));
#pragma unroll
        for (int n = 0; n < 8; ++n) { const bf16x8 b = *(const LAS bf16x8*)(B + t128(16 * n + fr, 4 * ks + fq)); acc[n] = __builtin_amdgcn_mfma_f32_16x16x32_bf16(b, a, acc[n], 0, 0, 0); } }
}
#define T_(i) (L + (i) * 32768)
#define SMF ((LAS float*)(L + 131072))

__device__ void mlstm_pass1(const Params& p, lds_u8* L, int item) {
    const int tid = threadIdx.x, wid = tid >> 6, lane = tid & 63, fr = lane & 15, fq = lane >> 4;
    const int bh = item >> 4, c = item & 15, b = bh >> 2, h = bh & 3, row0 = b * 2048 + c * 128;
    const bf16_t* P = (const bf16_t*)(p.ws + WS_PROJ) + (size_t)row0 * NP; const float* G = (const float*)(p.ws + WS_GATES) + (size_t)row0 * 8;
    LAS float* av = SMF; LAS float* wgv = SMF + 128;
    if (wid == 0) {
        const int t0 = 2 * lane; const float i0 = G[t0 * 8 + h], i1 = G[(t0 + 1) * 8 + h], lf0 = logsig(G[t0 * 8 + 4 + h]), lf1 = logsig(G[(t0 + 1) * 8 + 4 + h]);
        float s = lf0 + lf1;
        for (int o = 1; o < 64; o <<= 1) { const float t = __shfl_up(s, o); if (lane >= o) s += t; }
        const float b1 = s, b0 = s - lf1, a0 = i0 - b0, a1 = i1 - b1;
        float q = fmaxf(a0, a1);
        for (int o = 1; o < 64; o <<= 1) { const float t = __shfl_up(q, o); if (lane >= o) q = fmaxf(q, t); }
        float ex = __shfl_up(q, 1); if (lane == 0) ex = -INFINITY;
        const float pm0 = fmaxf(ex, a0), pm1 = q;
        float* bv_g = (float*)(p.ws + WS_BV) + item * 128; float* av_g = (float*)(p.ws + WS_AV) + item * 128; float* pm_g = (float*)(p.ws + WS_PM) + item * 128;
        bv_g[t0] = b0; bv_g[t0 + 1] = b1; av_g[t0] = a0; av_g[t0 + 1] = a1; pm_g[t0] = pm0; pm_g[t0 + 1] = pm1;
        const float PC = __shfl(q, 63);
        av[t0] = a0; av[t0 + 1] = a1; wgv[t0] = fexp(a0 - PC); wgv[t0 + 1] = fexp(a1 - PC);
        if (lane == 63) { ((float*)(p.ws + WS_BC))[item] = b1; ((float*)(p.ws + WS_PC))[item] = q; }
    }
    __syncthreads();
    stage_T(T_(2), P + 1024 + h * 128, NP, [&](int s, int, float v) { return v * wgv[s]; });
    stage_T(T_(1), P + 512 + h * 128, NP, [&](int, int, float v) { return v; });
    __syncthreads();
    f32x4 acc[8];
#pragma unroll
    for (int n = 0; n < 8; ++n) acc[n] = (f32x4){0.f, 0.f, 0.f, 0.f};
    mm16(acc, T_(2), 16 * wid, T_(1), fr, fq);
    float* cl = (float*)(p.ws + WS_H) + (size_t)item * 16384 + (16 * wid + fr) * 128 + 4 * fq;
#pragma unroll
    for (int n = 0; n < 8; ++n) *(f32x4*)(cl + 16 * n) = acc[n];
    { const int d = tid >> 2, q4 = tid & 3; float s = 0.f;
#pragma unroll
        for (int g = 0; g < 4; ++g) { const u32x4 w = *(const LAS u32x4*)(T_(1) + t128(d, 4 * q4 + g)); const int s0 = 32 * q4 + 8 * g;
#pragma unroll
            for (int i = 0; i < 4; ++i) s += bflo(w[i]) * wgv[s0 + 2 * i] + bfhi(w[i]) * wgv[s0 + 2 * i + 1]; }
        s += __shfl_xor(s, 1); s += __shfl_xor(s, 2);
        if (q4 == 0) ((float*)(p.ws + WS_NLOC))[item * 128 + d] = s; }
    __syncthreads();
}

__device__ void sample_item(const Params& p, lds_u8* L, int it) {
    const int tid = threadIdx.x, wid = tid >> 6, lane = tid & 63; const int bs = it >> 2, h = it & 3, row = TP + bs;
    const bf16_t* P = (const bf16_t*)(p.ws + WS_PROJ) + (size_t)row * NP; const float* G = (const float*)(p.ws + WS_GATES) + (size_t)row * 8;
    bf16_t* MIX = (bf16_t*)(p.ws + WS_MIX) + (size_t)row * D;
    LAS float* hb = SMF; LAS float* vsh = SMF + 128;
    const float ig = G[h], lf = logsig(G[4 + h]), m0 = p.in[6][bs * 4 + h];
    const float inter = lf + m0, mt = fmaxf(inter, ig), wi = fexp(ig - mt), wd = fexp(inter - mt);
    const int d4 = (lane & 31) * 4;
    float q4[4], k4[4];
    { const u32x2 qw = *(const u32x2*)(P + h * 128 + d4), kw = *(const u32x2*)(P + 512 + h * 128 + d4);
      q4[0] = bflo(qw.x); q4[1] = bfhi(qw.x); q4[2] = bflo(qw.y); q4[3] = bfhi(qw.y); k4[0] = bflo(kw.x); k4[1] = bfhi(kw.x); k4[2] = bflo(kw.y); k4[3] = bfhi(kw.y); }
    float qk = q4[0] * k4[0] + q4[1] * k4[1] + q4[2] * k4[2] + q4[3] * k4[3];
    for (int o = 16; o >= 1; o >>= 1) qk += __shfl_xor(qk, o);
    const f32x4 n0 = *(const f32x4*)(p.in[5] + (size_t)(bs * 4 + h) * 128 + d4);
    float nq = n0[0] * q4[0] + n0[1] * q4[1] + n0[2] * q4[2] + n0[3] * q4[3];
    for (int o = 16; o >= 1; o >>= 1) nq += __shfl_xor(nq, o);
    if (tid < 128) vsh[tid] = __uint_as_float(((unsigned)P[1024 + h * 128 + tid]) << 16);
    __syncthreads();
    const float s = qk * wi;
    const float* C0 = p.in[4] + (size_t)(bs * 4 + h) * 16384; float* C1 = p.out + O_CS + (size_t)(bs * 4 + h) * 16384;
#pragma unroll
    for (int i = 0; i < 8; ++i) { const int e = 16 * wid + 2 * i + (lane >> 5); const f32x4 cv = *(const f32x4*)(C0 + e * 128 + d4); const float ve = vsh[e];
        float cq = cv[0] * q4[0] + cv[1] * q4[1] + cv[2] * q4[2] + cv[3] * q4[3];
        for (int o = 16; o >= 1; o >>= 1) cq += __shfl_xor(cq, o);
        f32x4 cn; cn[0] = wd * cv[0] + wi * ve * k4[0]; cn[1] = wd * cv[1] + wi * ve * k4[1]; cn[2] = wd * cv[2] + wi * ve * k4[2]; cn[3] = wd * cv[3] + wi * ve * k4[3];
        *(f32x4*)(C1 + e * 128 + d4) = cn;
        if ((lane & 31) == 0) hb[e] = s * ve + wd * cq; }
    __syncthreads();
    if (wid == 0) {
        if (lane < 32) { f32x4 nn; nn[0] = wd * n0[0] + wi * k4[0]; nn[1] = wd * n0[1] + wi * k4[1]; nn[2] = wd * n0[2] + wi * k4[2]; nn[3] = wd * n0[3] + wi * k4[3];
            *(f32x4*)(p.out + O_NS + (size_t)(bs * 4 + h) * 128 + d4) = nn; }
        if (lane == 0) p.out[O_MS + bs * 4 + h] = mt;
        const float den = s + wd * nq, dn = fmaxf(fabsf(den), fexp(-mt)); const int e = 2 * lane;
        const float h0 = hb[e] / dn, h1 = hb[e + 1] / dn; const float ss = wsum(h0 * h0 + h1 * h1), rstd = 1.0f / sqrtf(ss * (1.0f / 128.0f) + 1e-6f);
        const unsigned ow = *(const unsigned*)(P + 1536 + h * 128 + e); const float* gh = p.in[12] + h * 128 + e;
        *(unsigned*)(MIX + h * 128 + e) = cvt_pk_bf16(h0 * rstd * gh[0] * bflo(ow), h1 * rstd * gh[1] * bfhi(ow));
    } else if (wid == 1) {
        const int e = 2 * lane; const unsigned vw = *(const unsigned*)(P + 2560 + h * 128 + e), uw = *(const unsigned*)(P + 2048 + h * 128 + e);
        const float x0 = bflo(vw), x1 = bfhi(vw); const float mean = wsum(x0 + x1) * (1.0f / 128.0f); const float d0 = x0 - mean, d1 = x1 - mean;
        const float var = wsum(d0 * d0 + d1 * d1) * (1.0f / 128.0f), rstd = 1.0f / sqrtf(var + 1e-6f);
        const float* lg = p.in[13] + h * 128 + e; const float* lb = p.in[14] + h * 128 + e;
        const float y0 = d0 * rstd * lg[0] + lb[0], y1 = d1 * rstd * lg[1] + lb[1];
        float* vo = p.out + O_VS + (size_t)(bs * 4 + h) * 128 + e; vo[0] = y0; vo[1] = y1;
        const float w00 = p.in[15][h * 16384], bs0 = p.in[16][h * 128];
        *(unsigned*)(MIX + 512 + h * 128 + e) = cvt_pk_bf16(bflo(uw) * (w00 * y0 + bs0), bfhi(uw) * (w00 * y1 + bs0));
    }
    __syncthreads();
}

__device__ void mlstm_scan(const Params& p) {
    const float* BC = (const float*)(p.ws + WS_BC); const float* PC = (const float*)(p.ws + WS_PC); const float* CL = (const float*)(p.ws + WS_H);
    bf16_t* CST = (bf16_t*)(p.ws + WS_ADA_CST); const float* NL = (const float*)(p.ws + WS_NLOC); float* NST = (float*)(p.ws + WS_NST); float* MST = (float*)(p.ws + WS_MST);
    for (int idx = blockIdx.x * 512 + threadIdx.x; idx < 32 * 4096; idx += gridDim.x * 512) {
        const int bh = idx >> 12, e4 = idx & 4095; float m = 0.f; f32x4 ca = {0.f, 0.f, 0.f, 0.f}, na = {0.f, 0.f, 0.f, 0.f};
        for (int c = 0; c < 16; ++c) { const int item = bh * 16 + c; const float P = PC[item], B = BC[item], mx = fmaxf(m, P), al = fexp(m - mx), be = fexp(P - mx);
            u32x2 w; w.x = cvt_pk_bf16(ca[0], ca[1]); w.y = cvt_pk_bf16(ca[2], ca[3]); *(u32x2*)(CST + (size_t)item * 16384 + e4 * 4) = w;
            const f32x4 cl = *(const f32x4*)(CL + (size_t)item * 16384 + e4 * 4); ca = al * ca + be * cl;
            if (e4 < 32) { *(f32x4*)(NST + item * 128 + e4 * 4) = na; const f32x4 nl = *(const f32x4*)(NL + item * 128 + e4 * 4); na = al * na + be * nl; }
            if (e4 == 0) MST[item] = m;
            m = B + mx; }
        *(f32x4*)(p.out + O_CP + (size_t)bh * 16384 + e4 * 4) = ca;
        if (e4 < 32) *(f32x4*)(p.out + O_NP + bh * 128 + e4 * 4) = na;
        if (e4 == 0) p.out[O_MP + bh] = m;
    }
}

__device__ void cmlp_item(const Params& p, lds_u8* L, int item) {
    const int tid = threadIdx.x, wid = tid >> 6, lane = tid & 63, fr = lane & 15, fq = lane >> 4;
    const int h = item & 3, bc = item >> 2, row0 = bc * 128;
    const bf16_t* P = (const bf16_t*)(p.ws + WS_PROJ) + (size_t)row0 * NP; bf16_t* MIX = (bf16_t*)(p.ws + WS_MIX) + (size_t)row0 * D;
    LAS float* mean_s = SMF; LAS float* rstd_s = SMF + 128; LAS float* lg_s = SMF + 256; LAS float* lb_s = SMF + 384;
    { const int s = tid >> 2, q4 = tid & 3; float x[32]; float sm = 0.f;
#pragma unroll
        for (int g = 0; g < 4; ++g) { const u32x4 w = *(const u32x4*)(P + (size_t)s * NP + 2560 + h * 128 + 32 * q4 + 8 * g);
#pragma unroll
            for (int i = 0; i < 4; ++i) { x[8 * g + 2 * i] = bflo(w[i]); x[8 * g + 2 * i + 1] = bfhi(w[i]); sm += x[8 * g + 2 * i] + x[8 * g + 2 * i + 1]; } }
        sm += __shfl_xor(sm, 1); sm += __shfl_xor(sm, 2); const float mean = sm * (1.0f / 128.0f); float vq = 0.f;
#pragma unroll
        for (int i = 0; i < 32; ++i) { const float d = x[i] - mean; vq += d * d; }
        vq += __shfl_xor(vq, 1); vq += __shfl_xor(vq, 2);
        if (q4 == 0) { mean_s[s] = mean; rstd_s[s] = 1.0f / sqrtf(vq * (1.0f / 128.0f) + 1e-6f); }
        if (tid < 128) { lg_s[tid] = p.in[13][h * 128 + tid]; lb_s[tid] = p.in[14][h * 128 + tid]; } }
    { const float* W = p.in[15] + (size_t)h * 16384;
#pragma unroll
        for (int i = 0; i < 4; ++i) { const int g = tid + 512 * i, n = g >> 4, k8 = g & 15; const f32x4 a = *(const f32x4*)(W + n * 128 + 8 * k8), b = *(const f32x4*)(W + n * 128 + 8 * k8 + 4);
            float v[8] = {a[0], a[1], a[2], a[3], b[0], b[1], b[2], b[3]};
#pragma unroll
            for (int j = 0; j < 8; ++j) if (8 * k8 + j > n) v[j] = 0.f;
            u32x4 w; w.x = cvt_pk_bf16(v[0], v[1]); w.y = cvt_pk_bf16(v[2], v[3]); w.z = cvt_pk_bf16(v[4], v[5]); w.w = cvt_pk_bf16(v[6], v[7]);
            *(LAS u32x4*)(T_(0) + t128(n, k8)) = w; } }
    __syncthreads();
    stage_T(T_(2), P + 2560 + h * 128, NP, [&](int s, int e, float v) { return (v - mean_s[s]) * rstd_s[s] * lg_s[e] + lb_s[e]; });
    __syncthreads();
    f32x4 acc[8];
#pragma unroll
    for (int n = 0; n < 8; ++n) acc[n] = (f32x4){0.f, 0.f, 0.f, 0.f};
    mm16(acc, T_(0), 16 * wid, T_(2), fr, fq);
    const int t = 16 * wid + fr; const float bsv = p.in[16][h * 128 + t];
#pragma unroll
    for (int n = 0; n < 8; ++n) { const int e = 16 * n + 4 * fq; const u32x2 uw = *(const u32x2*)(P + (size_t)t * NP + 2048 + h * 128 + e);
        u32x2 o; o.x = cvt_pk_bf16(bflo(uw.x) * (acc[n][0] + bsv), bfhi(uw.x) * (acc[n][1] + bsv)); o.y = cvt_pk_bf16(bflo(uw.y) * (acc[n][2] + bsv), bfhi(uw.y) * (acc[n][3] + bsv));
        *(u32x2*)(MIX + (size_t)t * D + 512 + h * 128 + e) = o; }
    __syncthreads();
}

__device__ void mlstm_pass3(const Params& p, lds_u8* L, int item) {
    const int tid = threadIdx.x, wid = tid >> 6, lane = tid & 63, fr = lane & 15, fq = lane >> 4;
    const int bh = item >> 4, c = item & 15, b = bh >> 2, h = bh & 3, row0 = b * 2048 + c * 128;
    const bf16_t* P = (const bf16_t*)(p.ws + WS_PROJ) + (size_t)row0 * NP; bf16_t* MIX = (bf16_t*)(p.ws + WS_MIX) + (size_t)row0 * D;
    LAS float* bv = SMF; LAS float* av = SMF + 128; LAS float* pm = SMF + 256; LAS float* ns = SMF + 384;
    stage_nat(T_(0), P + h * 128, NP); stage_nat(T_(1), P + 512 + h * 128, NP);
    stage_T(T_(2), P + 1024 + h * 128, NP, [&](int, int, float v) { return v; });
    stage_nat(T_(3), (const bf16_t*)(p.ws + WS_ADA_CST) + (size_t)item * 16384, 128);
    if (tid < 128) { bv[tid] = ((const float*)(p.ws + WS_BV))[item * 128 + tid]; av[tid] = ((const float*)(p.ws + WS_AV))[item * 128 + tid];
        pm[tid] = ((const float*)(p.ws + WS_PM))[item * 128 + tid]; ns[tid] = ((const float*)(p.ws + WS_NST))[item * 128 + tid]; }
    const float mc = ((const float*)(p.ws + WS_MST))[item];
    __syncthreads();
    const int t = 16 * wid + fr;
    f32x4 acc[8], acc2[8];
#pragma unroll
    for (int n = 0; n < 8; ++n) acc[n] = (f32x4){0.f, 0.f, 0.f, 0.f};
    mm16(acc, T_(0), 16 * wid, T_(1), fr, fq);
    float qn = 0.f;
#pragma unroll
    for (int g = 0; g < 4; ++g) { const u32x4 w = *(const LAS u32x4*)(T_(0) + t128(t, 4 * g + fq)); const int d0 = 8 * (4 * g + fq);
#pragma unroll
        for (int i = 0; i < 4; ++i) qn += bflo(w[i]) * ns[d0 + 2 * i] + bfhi(w[i]) * ns[d0 + 2 * i + 1]; }
    qn += __shfl_xor(qn, 16); qn += __shfl_xor(qn, 32);
    const float Mt = fmaxf(mc, pm[t]); float rs = 0.f;
    __syncthreads();
#pragma unroll
    for (int n = 0; n < 8; ++n) { const int s0 = 16 * n + 4 * fq; f32x4 sp;
#pragma unroll
        for (int j = 0; j < 4; ++j) { const int s = s0 + j; sp[j] = (s <= t) ? acc[n][j] * fexp(av[s] - Mt) : 0.f; rs += sp[j]; }
        u32x2 o; o.x = cvt_pk_bf16(sp[0], sp[1]); o.y = cvt_pk_bf16(sp[2], sp[3]);
        *(LAS u32x2*)(T_(1) + t * 256 + ((((s0 >> 3)) ^ ((t ^ (t >> 3)) & 15)) << 4) + (s0 & 7) * 2) = o; }
    rs += __shfl_xor(rs, 16); rs += __shfl_xor(rs, 32);
    const float winter = fexp(mc - Mt), den = rs + winter * qn, mtt = bv[t] + Mt, dn = fmaxf(fabsf(den), fexp(-mtt)), rdn = 1.0f / dn;
#pragma unroll
    for (int n = 0; n < 8; ++n) acc2[n] = (f32x4){0.f, 0.f, 0.f, 0.f};
    mm16(acc2, T_(0), 16 * wid, T_(3), fr, fq);
#pragma unroll
    for (int n = 0; n < 8; ++n) acc2[n] *= winter;
    asm volatile("s_waitcnt lgkmcnt(0)" ::: "memory"); __builtin_amdgcn_wave_barrier();
    mm16(acc2, T_(1), 16 * wid, T_(2), fr, fq);
    float ss = 0.f;
#pragma unroll
    for (int n = 0; n < 8; ++n) { acc2[n] *= rdn; ss += acc2[n][0] * acc2[n][0] + acc2[n][1] * acc2[n][1] + acc2[n][2] * acc2[n][2] + acc2[n][3] * acc2[n][3]; }
    ss += __shfl_xor(ss, 16); ss += __shfl_xor(ss, 32);
    const float rstd = 1.0f / sqrtf(ss * (1.0f / 128.0f) + 1e-6f);
#pragma unroll
    for (int n = 0; n < 8; ++n) { const int e = 16 * n + 4 * fq; const u32x2 ow = *(const u32x2*)(P + (size_t)t * NP + 1536 + h * 128 + e); const f32x4 gh = *(const f32x4*)(p.in[12] + h * 128 + e);
        u32x2 o; o.x = cvt_pk_bf16(acc2[n][0] * rstd * gh[0] * bflo(ow.x), acc2[n][1] * rstd * gh[1] * bfhi(ow.x)); o.y = cvt_pk_bf16(acc2[n][2] * rstd * gh[2] * bflo(ow.y), acc2[n][3] * rstd * gh[3] * bfhi(ow.y));
        *(u32x2*)(MIX + (size_t)t * D + h * 128 + e) = o; }
    __syncthreads();
}
#ifndef MULTI_LAUNCH
#define MULTI_LAUNCH 0
#endif
#ifndef PHASE_MASK
#define PHASE_MASK 0xFFF
#endif
#ifndef REPEAT_MASK
#define REPEAT_MASK 0
#endif
constexpr int N_PHASES = 12;
#define XB_TMO      128
#define XB_XCNT(j)  (256  + 64 * (j))
#define XB_XSUB(j)  (1280 + 64 * (j))
#define XB_XGEN(j)  (2304 + 64 * (j))
#define XB_TOP      3328
#define XB_TOPGEN   3392
#define XCD_BAR_WORDS 3456
#define XB_SPIN_CAP (1u << 18)

__device__ __forceinline__ unsigned xb_ld(unsigned* p)              { return __hip_atomic_load(p, __ATOMIC_RELAXED, __HIP_MEMORY_SCOPE_AGENT); }
__device__ __forceinline__ unsigned xb_add(unsigned* p, unsigned v) { return __hip_atomic_fetch_add(p, v, __ATOMIC_RELAXED, __HIP_MEMORY_SCOPE_AGENT); }
__device__ __forceinline__ unsigned xb_xcc_id() { return (unsigned)__builtin_amdgcn_s_getreg((3 << 11) | 20) & 0xFu; }
#define XB_SPIN(cond, bar) do { unsigned _sp = 0; while (cond) { __builtin_amdgcn_s_sleep(1); \
    if ((++_sp & 255u) == 0u) { if (xb_ld(&(bar)[XB_TMO])) break; if (_sp > XB_SPIN_CAP) { atomicAdd(&(bar)[XB_TMO], 1u); break; } } } } while (0)

struct XcdBarrier {
    unsigned* bar; unsigned x;
    volatile LAS unsigned* st;
};
__device__ __forceinline__ XcdBarrier xcd_barrier_post(unsigned* bar, volatile LAS unsigned* st) {
    XcdBarrier b; b.bar = bar; b.x = xb_xcc_id(); b.st = st;
    if (threadIdx.x == 0) (void)xb_add(&bar[XB_XCNT(b.x)], 1u);
    return b;
}
__device__ __forceinline__ void xcd_barrier_complete(unsigned* bar, unsigned x, unsigned& nloc, unsigned& nx) {
    const unsigned G = gridDim.x * gridDim.y * gridDim.z;
    unsigned sum, cnt, mine, sp = 0u;
    for (;;) {
        sum = 0u; cnt = 0u; mine = 0u;
#pragma unroll
        for (unsigned j = 0; j < 16; ++j) { const unsigned c = xb_ld(&bar[XB_XCNT(j)]); sum += c; cnt += (c > 0u) ? 1u : 0u; mine = (j == x) ? c : mine; }
        if (sum == G) break;
        __builtin_amdgcn_s_sleep(1);
        if ((++sp & 255u) == 0u) { if (xb_ld(&bar[XB_TMO])) break; if (sp > XB_SPIN_CAP) { atomicAdd(&bar[XB_TMO], 1u); break; } }
    }
    nloc = mine > 0u ? mine : 1u; nx = cnt > 0u ? cnt : 1u;
}

__device__ __forceinline__ void xcd_barrier(const XcdBarrier& b) {
    asm volatile("s_waitcnt vmcnt(0)" ::: "memory");
    __syncthreads();
    if (threadIdx.x == 0) {
        unsigned* bar = b.bar;
        __builtin_amdgcn_s_waitcnt(0);
        unsigned nloc = b.st[0], nx = b.st[1];
        if (nloc == 0u) { xcd_barrier_complete(bar, b.x, nloc, nx); b.st[0] = nloc; b.st[1] = nx; }
        const unsigned old = xb_add(&bar[XB_XSUB(b.x)], 1u);
        const unsigned gen = old / nloc;
        if (old + 1u == (gen + 1u) * nloc) {
            __builtin_amdgcn_fence(__ATOMIC_RELEASE, "agent");
            asm volatile("s_waitcnt vmcnt(0)" ::: "memory");
            const unsigned og = xb_add(&bar[XB_TOP], 1u);
            const unsigned tg = og / nx;
            if (og + 1u == (tg + 1u) * nx) xb_add(&bar[XB_TOPGEN], 1u);
            else XB_SPIN(xb_ld(&bar[XB_TOPGEN]) == tg, bar);
            __builtin_amdgcn_fence(__ATOMIC_ACQUIRE, "agent");
            xb_add(&bar[XB_XGEN(b.x)], 1u);
            asm volatile("s_waitcnt vmcnt(0)" ::: "memory");
        } else {
            XB_SPIN(xb_ld(&bar[XB_XGEN(b.x)]) == gen, bar);
            __builtin_amdgcn_fence(__ATOMIC_ACQUIRE, "agent");
            asm volatile("s_waitcnt vmcnt(0)" ::: "memory");
        }
    }
    __syncthreads();
}


__global__ void __launch_bounds__(512, 2) mk_fwd(Params p) {
    extern __shared__ __attribute__((aligned(16))) unsigned char lds_raw[];
    lds_u8* L = (lds_u8*)lds_raw;
    cg::grid_group grid = cg::this_grid();
    const int G = gridDim.x, bx = blockIdx.x;
    unsigned char* ws = p.ws;
    bf16_t* WinT = (bf16_t*)(ws + WS_WIN); bf16_t* WoutT = (bf16_t*)(ws + WS_WOUT); bf16_t* WguT = (bf16_t*)(ws + WS_WGU); bf16_t* WdT = (bf16_t*)(ws + WS_WD);
    bf16_t* WadaT = (bf16_t*)(ws + WS_ADA_CST); bf16_t* SC = (bf16_t*)(ws + WS_SC); float* MOD = (float*)(ws + WS_MOD);
    bf16_t* H = (bf16_t*)(ws + WS_H); bf16_t* PROJ = (bf16_t*)(ws + WS_PROJ); bf16_t* ACT = (bf16_t*)(ws + WS_PROJ); bf16_t* MIX = (bf16_t*)(ws + WS_MIX);
    LAS f32x4* red = (LAS f32x4*)(L + 131072);
    if (threadIdx.x < 16) ((LAS unsigned*)(L + 131072 + 8192))[threadIdx.x] = 0u;
    __syncthreads();
    XcdBarrier xb; xb.bar = (unsigned*)(ws + WS_BAR); xb.x = 0; xb.st = nullptr;
    if (!MULTI_LAUNCH) xb = xcd_barrier_post((unsigned*)(ws + WS_BAR), (volatile LAS unsigned*)(L + 131072 + 8192));
#define IN(k) (((PHASE_MASK >> (k)) & 1) && p.ph_lo <= (k) && (k) < p.ph_hi)
#define GBAR(k) do { if ((k) == 0) grid.sync(); else xcd_barrier(xb); } while (0)
#define PHASE(k) if (IN(k)) for (int rep_ = 0, nrep_ = (((REPEAT_MASK >> (k)) & 1) ? 2 : 1); rep_ < nrep_; ++rep_, ((rep_ < nrep_ || (k) + 1 < p.ph_hi) ? (void)[&]{ GBAR(k); }() : (void)0))

    PHASE(0) { phase_convert(p, L); }
    PHASE(1) {
        for (int u = bx; u < 384; u += G)
            sgemm_unit<8, 1, false>(red, SC, WadaT, D, 0, 9, u * 16, 0, [&](int r, int c, f32x4 a, f32x4) { if (r < 136) { const int col = u * 16 + c; *(f32x4*)(MOD + (size_t)r * NMOD + col) = a + *(const f32x4*)(p.in[8] + col); } }); }
    PHASE(2) { phase_norm<0>(p); }
    PHASE(3) {
        pg8::Gemm g{H, WinT, TP, NP, D}; pg8::StaticOrder S; S.init(TP, NP, G, bx); EpiProj E{PROJ};
        pg8::gemm_phase<EpiProj, pg8::StaticOrder>(L, g, S, E, nullptr);
        for (int u = bx; u < 192; u += G)
            sgemm_unit<8, 1, false>(red, H + (size_t)TP * D, WinT, D, 0, 8, u * 16, 0, [&](int r, int c, f32x4 a, f32x4) { E.small(TP + r, u * 16 + c, a); }); }
    PHASE(4) { for (int it = bx; it < 1024; it += G) { if (it < 512) mlstm_pass1(p, L, it); else sample_item(p, L, it - 512); } }
    PHASE(5) { mlstm_scan(p); for (int it = bx; it < 512; it += G) cmlp_item(p, L, it); }
    PHASE(6) { for (int it = bx; it < 512; it += G) mlstm_pass3(p, L, it); }
    PHASE(7) {
        pg8::Gemm g{MIX, WoutT, TP, D, D}; pg8::StaticOrder S; S.init(TP, D, G, bx); EpiRes E{p.in[0], MOD + 2048, p.out};
        pg8::gemm_phase<EpiRes, pg8::StaticOrder>(L, g, S, E, nullptr);
        for (int u = bx; u < 256; u += G) { const int ct = u >> 2, rg = u & 3;
            sgemm_unit<2, 4, false>(red, MIX + (size_t)TP * D, WoutT, D, rg * 2, 2, ct * 16, 0, [&](int r, int c, f32x4 a, f32x4) { const int col = ct * 16 + c;
                const f32x4 xv = *(const f32x4*)(p.in[1] + (size_t)r * D + col), gt = *(const f32x4*)(MOD + (size_t)(8 + r) * NMOD + 2048 + col); *(f32x4*)(p.out + (size_t)(TP + r) * D + col) = xv + gt * a; }); } }
    PHASE(8) { phase_norm<1>(p); }
    PHASE(9) {
        pg8::Gemm g{H, WguT, TP, 2 * DFF, D}; pg8::StaticOrder S; S.init(TP, 2 * DFF, G, bx); EpiSwi E{ACT};
        pg8::gemm_phase<EpiSwi, pg8::StaticOrder>(L, g, S, E, nullptr);
        for (int u = bx; u < 176; u += G) { const int br = (u >> 3) * 256 + (u & 7) * 16;
            sgemm_unit<8, 1, true>(red, H + (size_t)TP * D, WguT, D, 0, 8, br, br + 128, [&](int r, int c, f32x4 a, f32x4 b) { f32x4 v;
                for (int j = 0; j < 4; ++j) v[j] = a[j] * sigm(a[j]) * b[j];
                u32x2 w; w.x = cvt_pk_bf16(v[0], v[1]); w.y = cvt_pk_bf16(v[2], v[3]); *(u32x2*)(ACT + (size_t)(TP + r) * DFF + u * 16 + c) = w; }); } }
    PHASE(10) {
        pg8::Gemm g{ACT, WdT, TP, D, DFF}; pg8::StaticOrder S; S.init(TP, D, G, bx); EpiRes E{p.out, MOD + 5120, p.out};
        pg8::gemm_phase<EpiRes, pg8::StaticOrder>(L, g, S, E, nullptr);
        for (int u = bx; u < 256; u += G) { const int ct = u >> 2, rg = u & 3;
            sgemm_unit<2, 4, false>(red, ACT + (size_t)TP * DFF, WdT, DFF, rg * 2, 2, ct * 16, 0, [&](int r, int c, f32x4 a, f32x4) { const int col = ct * 16 + c;
                float* op = p.out + (size_t)(TP + r) * D + col; const f32x4 gt = *(const f32x4*)(MOD + (size_t)(8 + r) * NMOD + 5120 + col); *(f32x4*)op = *(const f32x4*)op + gt * a; }); } }
    PHASE(11) { phase_norm<2>(p); }
}

extern "C" void kernel_launch(void* const* d_in, const int* in_sizes, int n_in, void* d_out, int out_size, void* d_ws, size_t ws_size, hipStream_t stream) {
    static int grid = 0;
    if (grid == 0) {
        int dev = 0, cus = 0, per_cu = 0;
        (void)hipGetDevice(&dev); (void)hipDeviceGetAttribute(&cus, hipDeviceAttributeMultiprocessorCount, dev);
        if (hipFuncSetAttribute((const void*)mk_fwd, hipFuncAttributeMaxDynamicSharedMemorySize, LDS_BYTES) != hipSuccess) { fprintf(stderr, "kernel_launch: hipFuncSetAttribute failed\n"); grid = -1; return; }
        if (hipOccupancyMaxActiveBlocksPerMultiprocessor(&per_cu, (const void*)mk_fwd, 512, LDS_BYTES) != hipSuccess || per_cu < 1) { fprintf(stderr, "kernel_launch: occupancy query says %d\n", per_cu); per_cu = 1; }
        (void)hipGetLastError();
        grid = cus * per_cu;
        if (n_in != 22 || ws_size < WS_END) { fprintf(stderr, "kernel_launch: unexpected n_in %d / ws %zu\n", n_in, ws_size); grid = -1; return; }
    }
    if (grid < 0) return;
    Params p{};
    for (int i = 0; i < 22; ++i) p.in[i] = (const float*)d_in[i];
    p.out = (float*)d_out; p.ws = (unsigned char*)d_ws;
#if MULTI_LAUNCH
    for (int ph = 0; ph < N_PHASES; ++ph) { p.ph_lo = ph; p.ph_hi = ph + 1; hipLaunchKernelGGL(mk_fwd, dim3(grid), dim3(512), LDS_BYTES, stream, p); }
#else
    (void)hipMemsetAsync((unsigned char*)d_ws + WS_BAR, 0, XCD_BAR_WORDS * 4, stream);
    p.ph_lo = 0; p.ph_hi = N_PHASES;
    void* args[] = {&p};
    hipError_t e = hipLaunchCooperativeKernel((const void*)mk_fwd, dim3(grid), dim3(512), args, LDS_BYTES, stream);
    if (e != hipSuccess) fprintf(stderr, "kernel_launch: cooperative launch failed: %s (grid %d)\n", hipGetErrorString(e), grid);
#endif
}
```

```cpp
#include <hip/hip_cooperative_groups.h>
#include <cstdio>
#include <hip/hip_runtime.h>
namespace pg8 {
#define PG8_LAS __attribute__((address_space(3)))
typedef unsigned short bf16_t;
typedef short bf16x8 __attribute__((ext_vector_type(8)));
typedef float f32x4 __attribute__((ext_vector_type(4)));
typedef unsigned u32x4 __attribute__((ext_vector_type(4)));
constexpr int BM = 256, BK = 64, HALF = 128, HTB = HALF * BK * 2  , STAGE_BYTES = 8 * HTB, NXCD = 8, WGM = 8;

__host__ __device__ __forceinline__ int lds_byte(int r, int c) { const int st = (r >> 4) * 2 + (c >> 5), rr = r & 15, cc = c & 31, ob = rr * 64 + cc * 2; return st * 1024 + (ob ^ (((ob >> 9) & 1) << 5)); }
__host__ __device__ __forceinline__ void stage_rc(int b, int& R, int& C) { const int st = b / 1024, sb = b % 1024, swz = sb ^ (((sb >> 9) & 1) << 5); R = (st >> 1) * 16 + swz / 64; C = (st & 1) * 32 + (swz % 64) / 2; }
__host__ __device__ __forceinline__ int perm32(int rho) { const int n = rho >> 4, i = rho & 15; return 8 * (i >> 2) + 4 * n + (i & 3); }

struct Unit { int pm, pn; };
struct Gemm { const bf16_t* A; const bf16_t* Bt; int M, N, K; };

struct StaticOrder {
    int nM, nN, nwg, G, c;
    __host__ __device__ void init(int M, int N, int G_, int c_) { nM = M / BM; nN = N / BM; nwg = nM * nN; G = G_; c = c_; }
    __host__ __device__ bool next(int i, Unit& u) const {
        const long L = (long)i * G + c; if (L >= nwg) return false;
        int wgid = (int)L; { const int q = nwg / NXCD, r = nwg % NXCD, xcd = wgid % NXCD, off = wgid / NXCD; wgid = (xcd < r ? xcd * (q + 1) : r * (q + 1) + (xcd - r) * q) + off; }
        const int nig = WGM * nN, gid = wgid / nig, fm = gid * WGM, gsz = (nM - fm) < WGM ? (nM - fm) : WGM;
        u.pm = fm + ((wgid % nig) % gsz); u.pn = (wgid % nig) / gsz; return true;
    }
    __device__ __forceinline__ void a_ready(const Unit&) const {}
    __device__ __forceinline__ void done(const Unit&) const {}
};
struct CountedOrder : StaticOrder {
    const unsigned* ready; unsigned need; unsigned* tmo;
    __device__ __forceinline__ void a_ready(const Unit& u) const {
        if (threadIdx.x < 64) {
            const unsigned long long t0 = __builtin_amdgcn_s_memrealtime(); unsigned polls = 0;
            while ((unsigned)__builtin_amdgcn_readfirstlane(__hip_atomic_load(ready + 64 * u.pm, __ATOMIC_RELAXED, __HIP_MEMORY_SCOPE_AGENT)) < need) {
                if ((++polls & 255u) == 0u && __builtin_amdgcn_readfirstlane(__hip_atomic_load(tmo, __ATOMIC_RELAXED, __HIP_MEMORY_SCOPE_AGENT)) != 0u) break;
                if (__builtin_amdgcn_s_memrealtime() - t0 > 2000000ull) {
                    if (threadIdx.x == 0) { unsigned expect = 0u; __hip_atomic_compare_exchange_strong(tmo + 1, &expect, 0x600u | (unsigned)(u.pm & 0xff), __ATOMIC_RELAXED, __ATOMIC_RELAXED, __HIP_MEMORY_SCOPE_AGENT); __hip_atomic_store(tmo, 1u, __ATOMIC_RELAXED, __HIP_MEMORY_SCOPE_AGENT); }
                    break; }
                __builtin_amdgcn_s_sleep(2); }
            __builtin_amdgcn_fence(__ATOMIC_ACQUIRE, "agent");
            asm volatile("s_waitcnt vmcnt(0)" ::: "memory");
        }
#if !defined(BROKEN_HOOK_NO_BARRIER)
        asm volatile("" ::: "memory"); __builtin_amdgcn_s_barrier(); asm volatile("" ::: "memory");
#endif
    }
};

template <class Epi, class Sched, bool STAMP = false>
__device__ __forceinline__ void gemm_phase(PG8_LAS unsigned char* lds, const Gemm g, const Sched& S, const Epi& E, unsigned long long* stamps) {
    const int tid = threadIdx.x, wid = __builtin_amdgcn_readfirstlane(tid >> 6), lane = tid & 63, wr = wid >> 2, wc = wid & 3, fr = lane & 15, fq = lane >> 4;
    const int K = g.K, nt = K / BK;
    int ts_lo = 0, ts_hi = 0, nts = 0; const unsigned long long rt_entry = STAMP ? (unsigned long long)wall_clock64() : 0ull;
#define PG8_STAMP() do { if (STAMP && wid == 0 && nts < 64) { const unsigned long long _c = (unsigned long long)clock64(); \
        ts_lo = (lane == nts) ? (int)(unsigned)_c : ts_lo; ts_hi = (lane == nts) ? (int)(unsigned)(_c >> 32) : ts_hi; ++nts; } } while (0)
    PG8_STAMP();
    unsigned voffA[2], voffB[2];
#pragma unroll
    for (int i = 0; i < 2; ++i) { int R, C; stage_rc(tid * 16 + i * 8192, R, C); const int Rb = Epi::PERM ? ((R & ~31) + perm32(R & 31)) : R;
        voffA[i] = (unsigned)(R * K + C) * 2u; voffB[i] = (unsigned)(Rb * K + C) * 2u; }
    const size_t kstep = (size_t)(BK * 2);
    const size_t hstep = (size_t)HALF * K * 2;
    const size_t tstep = 2 * hstep;
    const unsigned ldsw = (unsigned)wid * 1024u;
    const int aoff = lds_byte(wr * 64 + fr, fq * 8), boff = lds_byte(wc * 32 + fr, fq * 8);
#define PG8_SA(b, h) (((b) * 2 + (h)) * HTB)
#define PG8_SB(b, h) ((4 + (b) * 2 + (h)) * HTB)
#define PG8_STAGE(bufoff, gbase, voff) do { _Pragma("unroll") for (int _i = 0; _i < 2; ++_i) \
        __builtin_amdgcn_global_load_lds((const unsigned*)((const char*)(gbase) + (voff)[_i]), (PG8_LAS unsigned*)(lds + (bufoff) + ldsw + _i * 8192), 16, 0, 0); } while (0)
#define PG8_LDA(dst, b, h) do { _Pragma("unroll") for (int m = 0; m < 4; ++m) _Pragma("unroll") for (int k = 0; k < 2; ++k) dst[m][k] = *(const PG8_LAS bf16x8*)(lds + PG8_SA(b, h) + aoff + m * 2048 + k * 1024); } while (0)
#define PG8_LDB(dst, b, h) do { _Pragma("unroll") for (int n = 0; n < 2; ++n) _Pragma("unroll") for (int k = 0; k < 2; ++k) dst[n][k] = *(const PG8_LAS bf16x8*)(lds + PG8_SB(b, h) + boff + n * 2048 + k * 1024); } while (0)
#define PG8_MMA(ai, bj, At, Bt) do { __builtin_amdgcn_s_setprio(1); _Pragma("unroll") for (int m = 0; m < 4; ++m) _Pragma("unroll") for (int n = 0; n < 2; ++n) _Pragma("unroll") for (int k = 0; k < 2; ++k) \
        acc[ai][bj][m][n] = __builtin_amdgcn_mfma_f32_16x16x32_bf16(Bt[n][k], At[m][k], acc[ai][bj][m][n], 0, 0, 0); __builtin_amdgcn_s_setprio(0); } while (0)
#define PG8_WAIT_V(n) asm volatile("s_waitcnt vmcnt(" #n ")" ::: "memory")
#define PG8_WAIT_L(n) asm volatile("s_waitcnt lgkmcnt(" #n ")" ::: "memory")
#define PG8_BAR __builtin_amdgcn_s_barrier()
#define PG8_SCHED __builtin_amdgcn_sched_barrier(0)
    Unit cur, nxt; int ui = 0;
    if (!S.next(0, cur)) return;
    f32x4 acc[2][2][4][2];
#pragma unroll
    for (int a = 0; a < 2; ++a)
#pragma unroll
        for (int b = 0; b < 2; ++b)
#pragma unroll
            for (int m = 0; m < 4; ++m)
#pragma unroll
                for (int n = 0; n < 2; ++n) acc[a][b][m][n] = (f32x4){0.f, 0.f, 0.f, 0.f};
    bf16x8 At[4][2], B0[2][2], B1[2][2];
    const char* cA = (const char*)g.A + (size_t)cur.pm * tstep; const char* cB = (const char*)g.Bt + (size_t)cur.pn * tstep;
    S.a_ready(cur);
    PG8_STAGE(PG8_SB(0, 0), cB, voffB); PG8_STAGE(PG8_SA(0, 0), cA, voffA); PG8_STAGE(PG8_SB(0, 1), cB + hstep, voffB); PG8_STAGE(PG8_SA(0, 1), cA + hstep, voffA);
    if (wr == 1) PG8_BAR;
    PG8_WAIT_V(4); PG8_BAR;
    PG8_STAGE(PG8_SB(1, 0), cB + kstep, voffB); PG8_STAGE(PG8_SA(1, 0), cA + kstep, voffA); PG8_STAGE(PG8_SB(1, 1), cB + hstep + kstep, voffB);
    PG8_WAIT_V(6); PG8_BAR;
    PG8_STAMP();
    for (;;) {
        const bool has_next = S.next(ui + 1, nxt);
        const char* nA = has_next ? (const char*)g.A + (size_t)nxt.pm * tstep : cA; const char* nB = has_next ? (const char*)g.Bt + (size_t)nxt.pn * tstep : cB;
        for (int t = 0; t < nt; t += 2) {
            const bool last = (t == nt - 2);
            const char* a1 = cA + (size_t)(t + 1) * kstep;
            const char* a2 = last ? nA : cA + (size_t)(t + 2) * kstep; const char* b2 = last ? nB : cB + (size_t)(t + 2) * kstep;
            const char* a3 = a2 + kstep; const char* b3 = b2 + kstep;
            if (last && has_next) S.a_ready(nxt);
            PG8_LDB(B0, 0, 0); PG8_SCHED; PG8_LDA(At, 0, 0); PG8_STAGE(PG8_SA(1, 1), a1 + hstep, voffA);
            PG8_WAIT_L(8); PG8_BAR; PG8_WAIT_L(0); PG8_MMA(0, 0, At, B0); PG8_BAR; PG8_SCHED;
            PG8_LDB(B1, 0, 1); PG8_STAGE(PG8_SB(0, 0), b2, voffB);
            PG8_BAR; PG8_WAIT_L(0); PG8_MMA(0, 1, At, B1); PG8_BAR;
            PG8_LDA(At, 0, 1); PG8_STAGE(PG8_SA(0, 0), a2, voffA);
            PG8_BAR; PG8_WAIT_L(0); PG8_MMA(1, 0, At, B0); PG8_BAR; PG8_SCHED;
            PG8_STAGE(PG8_SB(0, 1), b2 + hstep, voffB);
            PG8_WAIT_V(6); PG8_BAR; PG8_MMA(1, 1, At, B1); PG8_BAR;
            PG8_LDB(B0, 1, 0); PG8_SCHED; PG8_LDA(At, 1, 0); PG8_STAGE(PG8_SA(0, 1), a2 + hstep, voffA);
            PG8_WAIT_L(8); PG8_BAR; PG8_WAIT_L(0); PG8_MMA(0, 0, At, B0); PG8_BAR; PG8_SCHED;
            PG8_LDB(B1, 1, 1); PG8_STAGE(PG8_SB(1, 0), b3, voffB);
            PG8_BAR; PG8_WAIT_L(0); PG8_MMA(0, 1, At, B1); PG8_BAR;
            PG8_LDA(At, 1, 1); PG8_STAGE(PG8_SA(1, 0), a3, voffA);
            PG8_BAR; PG8_WAIT_L(0); PG8_MMA(1, 0, At, B0); PG8_BAR; PG8_SCHED;
            PG8_STAGE(PG8_SB(1, 1), b3 + hstep, voffB);
            PG8_WAIT_V(6); PG8_BAR; PG8_MMA(1, 1, At, B1); PG8_BAR;
        }
        PG8_STAMP();
        if constexpr (!Epi::AFTER_DRAIN) { E(acc, cur, wr, wc, fr, fq); S.done(cur); }
        PG8_STAMP();
        if (!has_next) break;
#pragma unroll
        for (int a = 0; a < 2; ++a)
#pragma unroll
            for (int b = 0; b < 2; ++b)
#pragma unroll
                for (int m = 0; m < 4; ++m)
#pragma unroll
                    for (int n = 0; n < 2; ++n) acc[a][b][m][n] = (f32x4){0.f, 0.f, 0.f, 0.f};
        cur = nxt; cA = nA; cB = nB; ++ui;
    }
    PG8_WAIT_V(0);
    if (wr == 0) PG8_BAR;
    PG8_BAR;
    if constexpr (Epi::AFTER_DRAIN) { E.fused(acc, cur, wr, wc, fr, fq, lds, wid, lane); S.done(cur); }
    PG8_STAMP();
    if (STAMP && wid == 0) { stamps[lane] = lane < nts ? (((unsigned long long)(unsigned)ts_hi << 32) | (unsigned)ts_lo) : 0ull;
        if (lane == 62) stamps[62] = rt_entry; if (lane == 63) stamps[63] = (unsigned long long)wall_clock64(); }
#undef PG8_STAMP
#undef PG8_SA
#undef PG8_SB
#undef PG8_STAGE
#undef PG8_LDA
#undef PG8_LDB
#undef PG8_MMA
#undef PG8_WAIT_V
#undef PG8_WAIT_L
#undef PG8_BAR
#undef PG8_SCHED
}
}
namespace cg = cooperative_groups;
using pg8::Unit;
#define LAS __attribute__((address_space(3)))
typedef LAS unsigned char lds_u8;
typedef unsigned short bf16_t;
typedef short bf16x8 __attribute__((ext_vector_type(8)));
typedef float f32x4 __attribute__((ext_vector_type(4)));
typedef unsigned u32x4 __attribute__((ext_vector_type(4)));
typedef unsigned u32x2 __attribute__((ext_vector_type(2)));

constexpr int D = 1024, TP = 16384, TS = 128, ROWS = TP + TS, NIN = 3080, NP = 3072, DFF = 2816, NMOD = 6144;
constexpr float LOG2E = 1.4426950408889634f;
constexpr int LDS_BYTES = 131072 + 8192 + 64;
constexpr size_t WS_WIN = 0, WS_WOUT = 6291456, WS_WGU = 8388608, WS_WD = 19922944, WS_ADA_CST = 25690112, WS_SC = 42467328,
    WS_MOD = 42762240, WS_GATES = 46104576, WS_H = 46632960, WS_PROJ = 80711680, WS_MIX = 182947840, WS_VEC = 217026560;
constexpr size_t WS_BV = WS_VEC, WS_AV = WS_VEC + 262144, WS_PM = WS_VEC + 2 * 262144, WS_NLOC = WS_VEC + 3 * 262144, WS_NST = WS_VEC + 4 * 262144,
    WS_BC = WS_VEC + 5 * 262144, WS_PC = WS_BC + 2048, WS_MST = WS_PC + 2048, WS_BAR = WS_MST + 2048, WS_END = WS_BAR + 16384;
constexpr size_t O_Y = 0, O_CP = 16908288, O_NP = 17432576, O_MP = 17436672, O_CS = 17436704, O_NS = 25825312, O_MS = 25890848, O_VS = 25891360;

struct Params { const float* in[22]; float* out; unsigned char* ws; int ph_lo, ph_hi; };

__device__ __forceinline__ unsigned cvt_pk_bf16(float lo, float hi) { unsigned r; asm("v_cvt_pk_bf16_f32 %0, %1, %2" : "=v"(r) : "v"(lo), "v"(hi)); return r; }
__device__ __forceinline__ float bflo(unsigned w) { return __uint_as_float(w << 16); }
__device__ __forceinline__ float bfhi(unsigned w) { return __uint_as_float(w & 0xffff0000u); }
__device__ __forceinline__ float fexp(float x) { return __builtin_amdgcn_exp2f(x * LOG2E); }
__device__ __forceinline__ float sigm(float x) { return __builtin_amdgcn_rcpf(1.0f + fexp(-x)); }
__device__ __forceinline__ float gelu_t(float x) { return x * sigm(1.5957691216057308f * x * (1.0f + 0.044715f * x * x)); }
__device__ __forceinline__ float logsig(float f) { return fminf(f, 0.f) - log1pf(expf(-fabsf(f))); }
__device__ __forceinline__ float wsum(float v) { for (int o = 32; o >= 1; o >>= 1) v += __shfl_xor(v, o); return v; }
__device__ __forceinline__ int mod_row(int row) { return row < TP ? (row >> 11) : (8 + row - TP); }

__device__ __forceinline__ f32x4 proj_act(int seg, f32x4 v) {
    if (seg == 0) { v *= 0.08838834764831845f; }
    else if (seg == 3) { for (int j = 0; j < 4; ++j) v[j] = sigm(v[j]); }
    else if (seg >= 4) { for (int j = 0; j < 4; ++j) v[j] = gelu_t(v[j]); }
    return v;
}
struct EpiProj {
    static constexpr bool PERM = false, AFTER_DRAIN = false;
    bf16_t* P;
    __device__ __forceinline__ void operator()(const f32x4 (&acc)[2][2][4][2], const Unit& u, int wr, int wc, int fr, int fq) const {
        const int seg = u.pn >> 1; const int row0 = u.pm * 256 + wr * 64 + fr, col0 = u.pn * 256 + wc * 32 + 4 * fq;
#pragma unroll
        for (int ai = 0; ai < 2; ++ai)
#pragma unroll
            for (int m = 0; m < 4; ++m) { bf16_t* rowp = P + (size_t)(row0 + ai * 128 + m * 16) * NP + col0;
#pragma unroll
                for (int bj = 0; bj < 2; ++bj)
#pragma unroll
                    for (int n = 0; n < 2; ++n) { const f32x4 v = proj_act(seg, acc[ai][bj][m][n]); u32x2 w; w.x = cvt_pk_bf16(v[0], v[1]); w.y = cvt_pk_bf16(v[2], v[3]);
                        *(u32x2*)(rowp + bj * 128 + n * 16) = w; } }
    }
    __device__ __forceinline__ void small(int row, int col, f32x4 v) const { v = proj_act(col >> 9, v); u32x2 w; w.x = cvt_pk_bf16(v[0], v[1]); w.y = cvt_pk_bf16(v[2], v[3]); *(u32x2*)(P + (size_t)row * NP + col) = w; }
};
struct EpiRes {
    static constexpr bool PERM = false, AFTER_DRAIN = false;
    const float* x; const float* gate; float* o;
    __device__ __forceinline__ void operator()(const f32x4 (&acc)[2][2][4][2], const Unit& u, int wr, int wc, int fr, int fq) const {
        const int row0 = u.pm * 256 + wr * 64 + fr, col0 = u.pn * 256 + wc * 32 + 4 * fq; const float* gp = gate + (size_t)(u.pm >> 3) * NMOD + col0;
        f32x4 g[2][2];
#pragma unroll
        for (int bj = 0; bj < 2; ++bj)
#pragma unroll
            for (int n = 0; n < 2; ++n) g[bj][n] = *(const f32x4*)(gp + bj * 128 + n * 16);
#pragma unroll
        for (int ai = 0; ai < 2; ++ai)
#pragma unroll
            for (int m = 0; m < 4; ++m) { const size_t off = (size_t)(row0 + ai * 128 + m * 16) * D + col0;
#pragma unroll
                for (int bj = 0; bj < 2; ++bj)
#pragma unroll
                    for (int n = 0; n < 2; ++n) { const f32x4 xv = *(const f32x4*)(x + off + bj * 128 + n * 16); *(f32x4*)(o + off + bj * 128 + n * 16) = xv + g[bj][n] * acc[ai][bj][m][n]; }
                asm volatile("" ::: "memory"); }
    }
};
struct EpiSwi {
    static constexpr bool PERM = false, AFTER_DRAIN = false;
    bf16_t* A;
    __device__ __forceinline__ void operator()(const f32x4 (&acc)[2][2][4][2], const Unit& u, int wr, int wc, int fr, int fq) const {
        const int row0 = u.pm * 256 + wr * 64 + fr, col0 = u.pn * 128 + wc * 32 + 4 * fq;
#pragma unroll
        for (int ai = 0; ai < 2; ++ai)
#pragma unroll
            for (int m = 0; m < 4; ++m) { bf16_t* rowp = A + (size_t)(row0 + ai * 128 + m * 16) * DFF + col0;
#pragma unroll
                for (int n = 0; n < 2; ++n) { const f32x4 a = acc[ai][0][m][n], b = acc[ai][1][m][n]; f32x4 r;
#pragma unroll
                    for (int j = 0; j < 4; ++j) r[j] = a[j] * sigm(a[j]) * b[j];
                    u32x2 w; w.x = cvt_pk_bf16(r[0], r[1]); w.y = cvt_pk_bf16(r[2], r[3]); *(u32x2*)(rowp + n * 16) = w; } }
    }
};

template <int RT, int KS, bool DUAL, class F>
__device__ __forceinline__ void sgemm_unit(LAS f32x4* red, const bf16_t* A, const bf16_t* Bt, int K, int rt0, int nrt, int brow0, int brow_dual, const F& f) {
    const int tid = threadIdx.x, wid = tid >> 6, lane = tid & 63, fr = lane & 15, fq = lane >> 4, rtl = wid % RT, ks = wid / RT;
    const int kb = ks * (K / KS), ke = kb + K / KS;
    for (int rt = rt0 + rtl; rt < rt0 + nrt; rt += RT) {
        f32x4 acc = {0.f, 0.f, 0.f, 0.f}, acc2 = {0.f, 0.f, 0.f, 0.f};
        const bf16_t* ap = A + (size_t)(rt * 16 + fr) * K + fq * 8; const bf16_t* bp = Bt + (size_t)(brow0 + fr) * K + fq * 8; const bf16_t* bp2 = Bt + (size_t)(brow_dual + fr) * K + fq * 8;
#pragma unroll 8
        for (int k = kb; k < ke; k += 32) {
            const bf16x8 a = *(const bf16x8*)(ap + k), b = *(const bf16x8*)(bp + k);
            acc = __builtin_amdgcn_mfma_f32_16x16x32_bf16(b, a, acc, 0, 0, 0);
            if (DUAL) { const bf16x8 b2 = *(const bf16x8*)(bp2 + k); acc2 = __builtin_amdgcn_mfma_f32_16x16x32_bf16(b2, a, acc2, 0, 0, 0); }
        }
        if (KS > 1) {
            red[wid * 64 + lane] = acc; __syncthreads();
            if (ks == 0) { for (int s = 1; s < KS; ++s) acc += red[(rtl + RT * s) * 64 + lane]; }
            __syncthreads();
            if (ks != 0) continue;
        }
        f(rt * 16 + fr, 4 * fq, acc, acc2);
    }
}
__device__ __forceinline__ void conv_unit(LAS float* T, const float* src, int ld_src, int k0, int c0, int c1, int c2, int c3, bf16_t* dst, int ldd, int n0) {
    const int tid = threadIdx.x; const int l16 = tid & 15, kr = tid >> 4; const int cb[4] = {c0, c1, c2, c3};
    f32x4 v[4][2];
#pragma unroll
    for (int sb = 0; sb < 4; ++sb)
#pragma unroll
        for (int ps = 0; ps < 2; ++ps) v[sb][ps] = __builtin_nontemporal_load((const f32x4*)(src + (size_t)(k0 + kr + 32 * ps) * ld_src + cb[sb] + 4 * l16));
#pragma unroll
    for (int sb = 0; sb < 4; ++sb)
#pragma unroll
        for (int ps = 0; ps < 2; ++ps)
#pragma unroll
            for (int i = 0; i < 4; ++i) T[sb * 4160 + (kr + 32 * ps) * 65 + 4 * l16 + i] = v[sb][ps][i];
    __syncthreads();
    const int kg = tid & 7, n = tid >> 3;
#pragma unroll
    for (int sb = 0; sb < 4; ++sb) { float x[8];
#pragma unroll
        for (int i = 0; i < 8; ++i) x[i] = T[sb * 4160 + (8 * kg + i) * 65 + n];
        u32x4 w; w.x = cvt_pk_bf16(x[0], x[1]); w.y = cvt_pk_bf16(x[2], x[3]); w.z = cvt_pk_bf16(x[4], x[5]); w.w = cvt_pk_bf16(x[6], x[7]);
        *(u32x4*)(dst + (size_t)(n0 + 64 * sb + n) * ldd + k0 + 8 * kg) = w; }
    __syncthreads();
}
__device__ void phase_convert(const Params& p, lds_u8* L) {
    LAS float* T = (LAS float*)L; unsigned char* ws = p.ws;
    const int NU = 1168 + 72;
    for (int u = blockIdx.x; u < NU; u += gridDim.x) {
        if (u < 384) { const int kb = u / 24, nb = u % 24, c = nb * 256; conv_unit(T, p.in[7], NMOD, kb * 64, c, c + 64, c + 128, c + 192, (bf16_t*)(ws + WS_ADA_CST), D, nb * 256); }
        else if (u < 576) { const int v = u - 384, kb = v / 12, nb = v % 12, c = nb * 256 + (nb >= 8 ? 8 : 0); conv_unit(T, p.in[10], NIN, kb * 64, c, c + 64, c + 128, c + 192, (bf16_t*)(ws + WS_WIN), D, nb * 256); }
        else if (u < 640) { const int v = u - 576, kb = v / 4, nb = v % 4, c = nb * 256; conv_unit(T, p.in[17], D, kb * 64, c, c + 64, c + 128, c + 192, (bf16_t*)(ws + WS_WOUT), D, nb * 256); }
        else if (u < 992) { const int v = u - 640, kb = v / 22, nb = v % 22, c = nb * 128; conv_unit(T, p.in[19], 2 * DFF, kb * 64, c, c + 64, DFF + c, DFF + c + 64, (bf16_t*)(ws + WS_WGU), D, nb * 256); }
        else if (u < 1168) { const int v = u - 992, kb = v / 4, nb = v % 4, c = nb * 256; conv_unit(T, p.in[20], D, kb * 64, c, c + 64, c + 128, c + 192, (bf16_t*)(ws + WS_WD), DFF, nb * 256); }
        else { const int v = u - 1168; const int idx = v * 512 + threadIdx.x;
            const int r = idx >> 8, c = (idx & 255) * 4; f32x4 x = {0.f, 0.f, 0.f, 0.f};
            if (r < 8) x = *(const f32x4*)(p.in[2] + r * D + c); else if (r < 136) x = *(const f32x4*)(p.in[3] + (r - 8) * D + c);
            u32x2 w; w.x = cvt_pk_bf16(x[0] * sigm(x[0]), x[1] * sigm(x[1])); w.y = cvt_pk_bf16(x[2] * sigm(x[2]), x[3] * sigm(x[3]));
            *(u32x2*)((bf16_t*)(ws + WS_SC) + r * D + c) = w; }
    }
}

template <int MODE> __device__ void phase_norm(const Params& p) {
    const int lane = threadIdx.x & 63, gw = blockIdx.x * 8 + (threadIdx.x >> 6), nW = gridDim.x * 8;
    const float* mod = (const float*)(p.ws + WS_MOD); bf16_t* H = (bf16_t*)(p.ws + WS_H); float* gates = (float*)(p.ws + WS_GATES);
    const float* gain = MODE == 0 ? p.in[9] : (MODE == 1 ? p.in[18] : p.in[21]);
    f32x4 gv[4];
#pragma unroll
    for (int j = 0; j < 4; ++j) gv[j] = *(const f32x4*)(gain + 4 * lane + 256 * j);
    f32x4 wg[4][4][2];
    if (MODE == 0) {
#pragma unroll
        for (int j = 0; j < 4; ++j)
#pragma unroll
            for (int i = 0; i < 4; ++i) { const float* wp = p.in[10] + (size_t)(4 * lane + 256 * j + i) * NIN + 2048; wg[j][i][0] = *(const f32x4*)wp; wg[j][i][1] = *(const f32x4*)(wp + 4); }
    }
    for (int r0 = gw; r0 < ROWS; r0 += 2 * nW) {
        const int r1 = r0 + nW; const bool has1 = r1 < ROWS; const int rr[2] = {r0, has1 ? r1 : r0};
        f32x4 xv[2][4]; float ss[2] = {0.f, 0.f};
#pragma unroll
        for (int q = 0; q < 2; ++q) { const int r = rr[q]; const float* src = MODE == 0 ? (r < TP ? p.in[0] + (size_t)r * D : p.in[1] + (size_t)(r - TP) * D) : p.out + (size_t)r * D;
#pragma unroll
            for (int j = 0; j < 4; ++j) xv[q][j] = *(const f32x4*)(src + 4 * lane + 256 * j); }
#pragma unroll
        for (int q = 0; q < 2; ++q) {
#pragma unroll
            for (int j = 0; j < 4; ++j) ss[q] += xv[q][j][0] * xv[q][j][0] + xv[q][j][1] * xv[q][j][1] + xv[q][j][2] * xv[q][j][2] + xv[q][j][3] * xv[q][j][3];
            ss[q] = wsum(ss[q]); }
#pragma unroll
        for (int q = 0; q < 2; ++q) { if (q == 1 && !has1) break;
            const int r = rr[q]; const float rstd = 1.0f / sqrtf(ss[q] * (1.0f / 1024.0f) + 1e-6f);
            if (MODE == 2) {
#pragma unroll
                for (int j = 0; j < 4; ++j) *(f32x4*)(p.out + (size_t)r * D + 4 * lane + 256 * j) = xv[q][j] * rstd * gv[j];
            } else {
                const float* mp = mod + (size_t)mod_row(r) * NMOD + (MODE == 0 ? 0 : 3072);
                f32x4 ga = {0.f, 0.f, 0.f, 0.f}, gb = {0.f, 0.f, 0.f, 0.f};
#pragma unroll
                for (int j = 0; j < 4; ++j) { const f32x4 sh = *(const f32x4*)(mp + 4 * lane + 256 * j), sc = *(const f32x4*)(mp + 1024 + 4 * lane + 256 * j);
                    const f32x4 h = xv[q][j] * rstd * gv[j] * (1.0f + sc) + sh;
                    u32x2 w; w.x = cvt_pk_bf16(h[0], h[1]); w.y = cvt_pk_bf16(h[2], h[3]); *(u32x2*)(H + (size_t)r * D + 4 * lane + 256 * j) = w;
                    if (MODE == 0) {
#pragma unroll
                        for (int i = 0; i < 4; ++i) { ga += h[i] * wg[j][i][0]; gb += h[i] * wg[j][i][1]; } } }
                if (MODE == 0) {
#pragma unroll
                    for (int i = 0; i < 4; ++i) { ga[i] = wsum(ga[i]); gb[i] = wsum(gb[i]); }
                    if (lane == 0) { const f32x4 b0 = *(const f32x4*)(p.in[11]), b1 = *(const f32x4*)(p.in[11] + 4); *(f32x4*)(gates + (size_t)r * 8) = ga + b0; *(f32x4*)(gates + (size_t)r * 8 + 4) = gb + b1; }
                }
            }
        }
    }
}

__device__ __forceinline__ int t128(int n, int k8) { return n * 256 + ((k8 ^ ((n ^ (n >> 3)) & 15)) << 4); }
__device__ __forceinline__ void stage_nat(lds_u8* T, const bf16_t* src, int ld) {
#pragma unroll
    for (int i = 0; i < 4; ++i) { const int g = threadIdx.x + 512 * i, n = g >> 4, k8 = g & 15; *(LAS u32x4*)(T + t128(n, k8)) = *(const u32x4*)(src + (size_t)n * ld + k8 * 8); }
}
template <class F> __device__ __forceinline__ void stage_T(lds_u8* T, const bf16_t* src, int ld, const F& xf) {
    const int rg = threadIdx.x >> 4, cg = threadIdx.x & 15; u32x4 r[4];
#pragma unroll
    for (int j = 0; j < 4; ++j) r[j] = *(const u32x4*)(src + (size_t)(4 * rg + j) * ld + 8 * cg);
#pragma unroll
    for (int i = 0; i < 8; ++i) { float v[4];
#pragma unroll
        for (int j = 0; j < 4; ++j) { const unsigned w = r[j][i >> 1]; v[j] = xf(4 * rg + j, 8 * cg + i, (i & 1) ? bfhi(w) : bflo(w)); }
        u32x2 o; o.x = cvt_pk_bf16(v[0], v[1]); o.y = cvt_pk_bf16(v[2], v[3]);
        const int n = 8 * cg + i; *(LAS u32x2*)(T + n * 256 + ((((rg >> 1)) ^ ((n ^ (n >> 3)) & 15)) << 4) + (rg & 1) * 8) = o; }
}
__device__ __forceinline__ void mm16(f32x4 (&acc)[8], const lds_u8* A, int arow0, const lds_u8* B, int fr, int fq) {
#pragma unroll 1
    for (int ks = 0; ks < 4; ++ks) { const bf16x8 a = *(const LAS bf16x8*)(A + t128(arow0 + fr, 4 * ks + fq));
#pragma unroll
        for (int n = 0; n < 8; ++n) { const bf16x8 b = *(const LAS bf16x8*)(B + t128(16 * n + fr, 4 * ks + fq)); acc[n] = __builtin_amdgcn_mfma_f32_16x16x32_bf16(b, a, acc[n], 0, 0, 0); } }
}
#define T_(i) (L + (i) * 32768)
#define SMF ((LAS float*)(L + 131072))

__device__ void mlstm_pass1(const Params& p, lds_u8* L, int item) {
    const int tid = threadIdx.x, wid = tid >> 6, lane = tid & 63, fr = lane & 15, fq = lane >> 4;
    const int bh = item >> 4, c = item & 15, b = bh >> 2, h = bh & 3, row0 = b * 2048 + c * 128;
    const bf16_t* P = (const bf16_t*)(p.ws + WS_PROJ) + (size_t)row0 * NP; const float* G = (const float*)(p.ws + WS_GATES) + (size_t)row0 * 8;
    LAS float* av = SMF; LAS float* wgv = SMF + 128;
    if (wid == 0) {
        const int t0 = 2 * lane; const float i0 = G[t0 * 8 + h], i1 = G[(t0 + 1) * 8 + h], lf0 = logsig(G[t0 * 8 + 4 + h]), lf1 = logsig(G[(t0 + 1) * 8 + 4 + h]);
        float s = lf0 + lf1;
        for (int o = 1; o < 64; o <<= 1) { const float t = __shfl_up(s, o); if (lane >= o) s += t; }
        const float b1 = s, b0 = s - lf1, a0 = i0 - b0, a1 = i1 - b1;
        float q = fmaxf(a0, a1);
        for (int o = 1; o < 64; o <<= 1) { const float t = __shfl_up(q, o); if (lane >= o) q = fmaxf(q, t); }
        float ex = __shfl_up(q, 1); if (lane == 0) ex = -INFINITY;
        const float pm0 = fmaxf(ex, a0), pm1 = q;
        float* bv_g = (float*)(p.ws + WS_BV) + item * 128; float* av_g = (float*)(p.ws + WS_AV) + item * 128; float* pm_g = (float*)(p.ws + WS_PM) + item * 128;
        bv_g[t0] = b0; bv_g[t0 + 1] = b1; av_g[t0] = a0; av_g[t0 + 1] = a1; pm_g[t0] = pm0; pm_g[t0 + 1] = pm1;
        const float PC = __shfl(q, 63);
        av[t0] = a0; av[t0 + 1] = a1; wgv[t0] = fexp(a0 - PC); wgv[t0 + 1] = fexp(a1 - PC);
        if (lane == 63) { ((float*)(p.ws + WS_BC))[item] = b1; ((float*)(p.ws + WS_PC))[item] = q; }
    }
    __syncthreads();
    stage_T(T_(2), P + 1024 + h * 128, NP, [&](int s, int, float v) { return v * wgv[s]; });
    stage_T(T_(1), P + 512 + h * 128, NP, [&](int, int, float v) { return v; });
    __syncthreads();
    f32x4 acc[8];
#pragma unroll
    for (int n = 0; n < 8; ++n) acc[n] = (f32x4){0.f, 0.f, 0.f, 0.f};
    mm16(acc, T_(2), 16 * wid, T_(1), fr, fq);
    float* cl = (float*)(p.ws + WS_H) + (size_t)item * 16384 + (16 * wid + fr) * 128 + 4 * fq;
#pragma unroll
    for (int n = 0; n < 8; ++n) *(f32x4*)(cl + 16 * n) = acc[n];
    { const int d = tid >> 2, q4 = tid & 3; float s = 0.f;
#pragma unroll
        for (int g = 0; g < 4; ++g) { const u32x4 w = *(const LAS u32x4*)(T_(1) + t128(d, 4 * q4 + g)); const int s0 = 32 * q4 + 8 * g;
#pragma unroll
            for (int i = 0; i < 4; ++i) s += bflo(w[i]) * wgv[s0 + 2 * i] + bfhi(w[i]) * wgv[s0 + 2 * i + 1]; }
        s += __shfl_xor(s, 1); s += __shfl_xor(s, 2);
        if (q4 == 0) ((float*)(p.ws + WS_NLOC))[item * 128 + d] = s; }
    __syncthreads();
}

__device__ void sample_item(const Params& p, lds_u8* L, int it) {
    const int tid = threadIdx.x, wid = tid >> 6, lane = tid & 63; const int bs = it >> 2, h = it & 3, row = TP + bs;
    const bf16_t* P = (const bf16_t*)(p.ws + WS_PROJ) + (size_t)row * NP; const float* G = (const float*)(p.ws + WS_GATES) + (size_t)row * 8;
    bf16_t* MIX = (bf16_t*)(p.ws + WS_MIX) + (size_t)row * D;
    LAS float* hb = SMF; LAS float* vsh = SMF + 128;
    const float ig = G[h], lf = logsig(G[4 + h]), m0 = p.in[6][bs * 4 + h];
    const float inter = lf + m0, mt = fmaxf(inter, ig), wi = fexp(ig - mt), wd = fexp(inter - mt);
    const int d4 = (lane & 31) * 4;
    float q4[4], k4[4];
    { const u32x2 qw = *(const u32x2*)(P + h * 128 + d4), kw = *(const u32x2*)(P + 512 + h * 128 + d4);
      q4[0] = bflo(qw.x); q4[1] = bfhi(qw.x); q4[2] = bflo(qw.y); q4[3] = bfhi(qw.y); k4[0] = bflo(kw.x); k4[1] = bfhi(kw.x); k4[2] = bflo(kw.y); k4[3] = bfhi(kw.y); }
    float qk = q4[0] * k4[0] + q4[1] * k4[1] + q4[2] * k4[2] + q4[3] * k4[3];
    for (int o = 16; o >= 1; o >>= 1) qk += __shfl_xor(qk, o);
    const f32x4 n0 = *(const f32x4*)(p.in[5] + (size_t)(bs * 4 + h) * 128 + d4);
    float nq = n0[0] * q4[0] + n0[1] * q4[1] + n0[2] * q4[2] + n0[3] * q4[3];
    for (int o = 16; o >= 1; o >>= 1) nq += __shfl_xor(nq, o);
    if (tid < 128) vsh[tid] = __uint_as_float(((unsigned)P[1024 + h * 128 + tid]) << 16);
    __syncthreads();
    const float s = qk * wi;
    const float* C0 = p.in[4] + (size_t)(bs * 4 + h) * 16384; float* C1 = p.out + O_CS + (size_t)(bs * 4 + h) * 16384;
#pragma unroll
    for (int i = 0; i < 8; ++i) { const int e = 16 * wid + 2 * i + (lane >> 5); const f32x4 cv = *(const f32x4*)(C0 + e * 128 + d4); const float ve = vsh[e];
        float cq = cv[0] * q4[0] + cv[1] * q4[1] + cv[2] * q4[2] + cv[3] * q4[3];
        for (int o = 16; o >= 1; o >>= 1) cq += __shfl_xor(cq, o);
        f32x4 cn; cn[0] = wd * cv[0] + wi * ve * k4[0]; cn[1] = wd * cv[1] + wi * ve * k4[1]; cn[2] = wd * cv[2] + wi * ve * k4[2]; cn[3] = wd * cv[3] + wi * ve * k4[3];
        *(f32x4*)(C1 + e * 128 + d4) = cn;
        if ((lane & 31) == 0) hb[e] = s * ve + wd * cq; }
    __syncthreads();
    if (wid == 0) {
        if (lane < 32) { f32x4 nn; nn[0] = wd * n0[0] + wi * k4[0]; nn[1] = wd * n0[1] + wi * k4[1]; nn[2] = wd * n0[2] + wi * k4[2]; nn[3] = wd * n0[3] + wi * k4[3];
            *(f32x4*)(p.out + O_NS + (size_t)(bs * 4 + h) * 128 + d4) = nn; }
        if (lane == 0) p.out[O_MS + bs * 4 + h] = mt;
        const float den = s + wd * nq, dn = fmaxf(fabsf(den), fexp(-mt)); const int e = 2 * lane;
        const float h0 = hb[e] / dn, h1 = hb[e + 1] / dn; const float ss = wsum(h0 * h0 + h1 * h1), rstd = 1.0f / sqrtf(ss * (1.0f / 128.0f) + 1e-6f);
        const unsigned ow = *(const unsigned*)(P + 1536 + h * 128 + e); const float* gh = p.in[12] + h * 128 + e;
        *(unsigned*)(MIX + h * 128 + e) = cvt_pk_bf16(h0 * rstd * gh[0] * bflo(ow), h1 * rstd * gh[1] * bfhi(ow));
    } else if (wid == 1) {
        const int e = 2 * lane; const unsigned vw = *(const unsigned*)(P + 2560 + h * 128 + e), uw = *(const unsigned*)(P + 2048 + h * 128 + e);
        const float x0 = bflo(vw), x1 = bfhi(vw); const float mean = wsum(x0 + x1) * (1.0f / 128.0f); const float d0 = x0 - mean, d1 = x1 - mean;
        const float var = wsum(d0 * d0 + d1 * d1) * (1.0f / 128.0f), rstd = 1.0f / sqrtf(var + 1e-6f);
        const float* lg = p.in[13] + h * 128 + e; const float* lb = p.in[14] + h * 128 + e;
        const float y0 = d0 * rstd * lg[0] + lb[0], y1 = d1 * rstd * lg[1] + lb[1];
        float* vo = p.out + O_VS + (size_t)(bs * 4 + h) * 128 + e; vo[0] = y0; vo[1] = y1;
        const float w00 = p.in[15][h * 16384], bs0 = p.in[16][h * 128];
        *(unsigned*)(MIX + 512 + h * 128 + e) = cvt_pk_bf16(bflo(uw) * (w00 * y0 + bs0), bfhi(uw) * (w00 * y1 + bs0));
    }
    __syncthreads();
}

__device__ void mlstm_scan(const Params& p) {
    const float* BC = (const float*)(p.ws + WS_BC); const float* PC = (const float*)(p.ws + WS_PC); const float* CL = (const float*)(p.ws + WS_H);
    bf16_t* CST = (bf16_t*)(p.ws + WS_ADA_CST); const float* NL = (const float*)(p.ws + WS_NLOC); float* NST = (float*)(p.ws + WS_NST); float* MST = (float*)(p.ws + WS_MST);
    for (int idx = blockIdx.x * 512 + threadIdx.x; idx < 32 * 4096; idx += gridDim.x * 512) {
        const int bh = idx >> 12, e4 = idx & 4095; float m = 0.f; f32x4 ca = {0.f, 0.f, 0.f, 0.f}, na = {0.f, 0.f, 0.f, 0.f};
        f32x4 cl[16], nl[16];
#pragma unroll
        for (int c = 0; c < 16; ++c) { cl[c] = __builtin_nontemporal_load((const f32x4*)(CL + (size_t)(bh * 16 + c) * 16384 + e4 * 4)); nl[c] = (f32x4){0.f, 0.f, 0.f, 0.f}; }
        if (e4 < 32) {
#pragma unroll
            for (int c = 0; c < 16; ++c) nl[c] = *(const f32x4*)(NL + (bh * 16 + c) * 128 + e4 * 4); }
#pragma unroll
        for (int c = 0; c < 16; ++c) { const int item = bh * 16 + c; const float P = PC[item], B = BC[item], mx = fmaxf(m, P), al = fexp(m - mx), be = fexp(P - mx);
            u32x2 w; w.x = cvt_pk_bf16(ca[0], ca[1]); w.y = cvt_pk_bf16(ca[2], ca[3]); *(u32x2*)(CST + (size_t)item * 16384 + e4 * 4) = w;
            ca = al * ca + be * cl[c];
            if (e4 < 32) { *(f32x4*)(NST + item * 128 + e4 * 4) = na; na = al * na + be * nl[c]; }
            if (e4 == 0) MST[item] = m;
            m = B + mx; }
        *(f32x4*)(p.out + O_CP + (size_t)bh * 16384 + e4 * 4) = ca;
        if (e4 < 32) *(f32x4*)(p.out + O_NP + bh * 128 + e4 * 4) = na;
        if (e4 == 0) p.out[O_MP + bh] = m;
    }
}

__device__ void cmlp_item(const Params& p, lds_u8* L, int item) {
    const int tid = threadIdx.x, wid = tid >> 6, lane = tid & 63, fr = lane & 15, fq = lane >> 4;
    const int h = item & 3, bc = item >> 2, row0 = bc * 128;
    const bf16_t* P = (const bf16_t*)(p.ws + WS_PROJ) + (size_t)row0 * NP; bf16_t* MIX = (bf16_t*)(p.ws + WS_MIX) + (size_t)row0 * D;
    LAS float* mean_s = SMF; LAS float* rstd_s = SMF + 128; LAS float* lg_s = SMF + 256; LAS float* lb_s = SMF + 384;
    { const int s = tid >> 2, q4 = tid & 3; float x[32]; float sm = 0.f;
#pragma unroll
        for (int g = 0; g < 4; ++g) { const u32x4 w = *(const u32x4*)(P + (size_t)s * NP + 2560 + h * 128 + 32 * q4 + 8 * g);
#pragma unroll
            for (int i = 0; i < 4; ++i) { x[8 * g + 2 * i] = bflo(w[i]); x[8 * g + 2 * i + 1] = bfhi(w[i]); sm += x[8 * g + 2 * i] + x[8 * g + 2 * i + 1]; } }
        sm += __shfl_xor(sm, 1); sm += __shfl_xor(sm, 2); const float mean = sm * (1.0f / 128.0f); float vq = 0.f;
#pragma unroll
        for (int i = 0; i < 32; ++i) { const float d = x[i] - mean; vq += d * d; }
        vq += __shfl_xor(vq, 1); vq += __shfl_xor(vq, 2);
        if (q4 == 0) { mean_s[s] = mean; rstd_s[s] = 1.0f / sqrtf(vq * (1.0f / 128.0f) + 1e-6f); }
        if (tid < 128) { lg_s[tid] = p.in[13][h * 128 + tid]; lb_s[tid] = p.in[14][h * 128 + tid]; } }
    { const float* W = p.in[15] + (size_t)h * 16384;
#pragma unroll
        for (int i = 0; i < 4; ++i) { const int g = tid + 512 * i, n = g >> 4, k8 = g & 15; const f32x4 a = *(const f32x4*)(W + n * 128 + 8 * k8), b = *(const f32x4*)(W + n * 128 + 8 * k8 + 4);
            float v[8] = {a[0], a[1], a[2], a[3], b[0], b[1], b[2], b[3]};
#pragma unroll
            for (int j = 0; j < 8; ++j) if (8 * k8 + j > n) v[j] = 0.f;
            u32x4 w; w.x = cvt_pk_bf16(v[0], v[1]); w.y = cvt_pk_bf16(v[2], v[3]); w.z = cvt_pk_bf16(v[4], v[5]); w.w = cvt_pk_bf16(v[6], v[7]);
            *(LAS u32x4*)(T_(0) + t128(n, k8)) = w; } }
    __syncthreads();
    stage_T(T_(2), P + 2560 + h * 128, NP, [&](int s, int e, float v) { return (v - mean_s[s]) * rstd_s[s] * lg_s[e] + lb_s[e]; });
    __syncthreads();
    f32x4 acc[8];
#pragma unroll
    for (int n = 0; n < 8; ++n) acc[n] = (f32x4){0.f, 0.f, 0.f, 0.f};
    mm16(acc, T_(0), 16 * wid, T_(2), fr, fq);
    const int t = 16 * wid + fr; const float bsv = p.in[16][h * 128 + t];
#pragma unroll
    for (int n = 0; n < 8; ++n) { const int e = 16 * n + 4 * fq; const u32x2 uw = *(const u32x2*)(P + (size_t)t * NP + 2048 + h * 128 + e);
        u32x2 o; o.x = cvt_pk_bf16(bflo(uw.x) * (acc[n][0] + bsv), bfhi(uw.x) * (acc[n][1] + bsv)); o.y = cvt_pk_bf16(bflo(uw.y) * (acc[n][2] + bsv), bfhi(uw.y) * (acc[n][3] + bsv));
        *(u32x2*)(MIX + (size_t)t * D + 512 + h * 128 + e) = o; }
    __syncthreads();
}

__device__ void mlstm_pass3(const Params& p, lds_u8* L, int item) {
    const int tid = threadIdx.x, wid = tid >> 6, lane = tid & 63, fr = lane & 15, fq = lane >> 4;
    const int bh = item >> 4, c = item & 15, b = bh >> 2, h = bh & 3, row0 = b * 2048 + c * 128;
    const bf16_t* P = (const bf16_t*)(p.ws + WS_PROJ) + (size_t)row0 * NP; bf16_t* MIX = (bf16_t*)(p.ws + WS_MIX) + (size_t)row0 * D;
    LAS float* bv = SMF; LAS float* av = SMF + 128; LAS float* pm = SMF + 256; LAS float* ns = SMF + 384;
    stage_nat(T_(0), P + h * 128, NP); stage_nat(T_(1), P + 512 + h * 128, NP);
    stage_T(T_(2), P + 1024 + h * 128, NP, [&](int, int, float v) { return v; });
    stage_nat(T_(3), (const bf16_t*)(p.ws + WS_ADA_CST) + (size_t)item * 16384, 128);
    if (tid < 128) { bv[tid] = ((const float*)(p.ws + WS_BV))[item * 128 + tid]; av[tid] = ((const float*)(p.ws + WS_AV))[item * 128 + tid];
        pm[tid] = ((const float*)(p.ws + WS_PM))[item * 128 + tid]; ns[tid] = ((const float*)(p.ws + WS_NST))[item * 128 + tid]; }
    const float mc = ((const float*)(p.ws + WS_MST))[item];
    __syncthreads();
    const int t = 16 * wid + fr;
    f32x4 acc[8], acc2[8];
#pragma unroll
    for (int n = 0; n < 8; ++n) acc[n] = (f32x4){0.f, 0.f, 0.f, 0.f};
    mm16(acc, T_(0), 16 * wid, T_(1), fr, fq);
    float qn = 0.f;
#pragma unroll
    for (int g = 0; g < 4; ++g) { const u32x4 w = *(const LAS u32x4*)(T_(0) + t128(t, 4 * g + fq)); const int d0 = 8 * (4 * g + fq);
#pragma unroll
        for (int i = 0; i < 4; ++i) qn += bflo(w[i]) * ns[d0 + 2 * i] + bfhi(w[i]) * ns[d0 + 2 * i + 1]; }
    qn += __shfl_xor(qn, 16); qn += __shfl_xor(qn, 32);
    const float Mt = fmaxf(mc, pm[t]); float rs = 0.f;
    __syncthreads();
#pragma unroll
    for (int n = 0; n < 8; ++n) { const int s0 = 16 * n + 4 * fq; f32x4 sp;
#pragma unroll
        for (int j = 0; j < 4; ++j) { const int s = s0 + j; sp[j] = (s <= t) ? acc[n][j] * fexp(av[s] - Mt) : 0.f; rs += sp[j]; }
        u32x2 o; o.x = cvt_pk_bf16(sp[0], sp[1]); o.y = cvt_pk_bf16(sp[2], sp[3]);
        *(LAS u32x2*)(T_(1) + t * 256 + ((((s0 >> 3)) ^ ((t ^ (t >> 3)) & 15)) << 4) + (s0 & 7) * 2) = o; }
    rs += __shfl_xor(rs, 16); rs += __shfl_xor(rs, 32);
    const float winter = fexp(mc - Mt), den = rs + winter * qn, mtt = bv[t] + Mt, dn = fmaxf(fabsf(den), fexp(-mtt)), rdn = 1.0f / dn;
#pragma unroll
    for (int n = 0; n < 8; ++n) acc2[n] = (f32x4){0.f, 0.f, 0.f, 0.f};
    mm16(acc2, T_(0), 16 * wid, T_(3), fr, fq);
#pragma unroll
    for (int n = 0; n < 8; ++n) acc2[n] *= winter;
    asm volatile("s_waitcnt lgkmcnt(0)" ::: "memory"); __builtin_amdgcn_wave_barrier();
    mm16(acc2, T_(1), 16 * wid, T_(2), fr, fq);
    float ss = 0.f;
#pragma unroll
    for (int n = 0; n < 8; ++n) { acc2[n] *= rdn; ss += acc2[n][0] * acc2[n][0] + acc2[n][1] * acc2[n][1] + acc2[n][2] * acc2[n][2] + acc2[n][3] * acc2[n][3]; }
    ss += __shfl_xor(ss, 16); ss += __shfl_xor(ss, 32);
    const float rstd = 1.0f / sqrtf(ss * (1.0f / 128.0f) + 1e-6f);
#pragma unroll
    for (int n = 0; n < 8; ++n) { const int e = 16 * n + 4 * fq; const u32x2 ow = *(const u32x2*)(P + (size_t)t * NP + 1536 + h * 128 + e); const f32x4 gh = *(const f32x4*)(p.in[12] + h * 128 + e);
        u32x2 o; o.x = cvt_pk_bf16(acc2[n][0] * rstd * gh[0] * bflo(ow.x), acc2[n][1] * rstd * gh[1] * bfhi(ow.x)); o.y = cvt_pk_bf16(acc2[n][2] * rstd * gh[2] * bflo(ow.y), acc2[n][3] * rstd * gh[3] * bfhi(ow.y));
        *(u32x2*)(MIX + (size_t)t * D + h * 128 + e) = o; }
    __syncthreads();
}
#ifndef MULTI_LAUNCH
#define MULTI_LAUNCH 0
#endif
#ifndef PHASE_MASK
#define PHASE_MASK 0xFFF
#endif
#ifndef REPEAT_MASK
#define REPEAT_MASK 0
#endif
#ifndef HOST_REPEAT_MASK
#define HOST_REPEAT_MASK 0
#endif
constexpr int N_PHASES = 12;
#define XB_TMO      128
#define XB_XCNT(j)  (256  + 64 * (j))
#define XB_XSUB(j)  (1280 + 64 * (j))
#define XB_XGEN(j)  (2304 + 64 * (j))
#define XB_TOP      3328
#define XB_TOPGEN   3392
#define XCD_BAR_WORDS 3456
#define XB_SPIN_CAP (1u << 18)

__device__ __forceinline__ unsigned xb_ld(unsigned* p)              { return __hip_atomic_load(p, __ATOMIC_RELAXED, __HIP_MEMORY_SCOPE_AGENT); }
__device__ __forceinline__ unsigned xb_add(unsigned* p, unsigned v) { return __hip_atomic_fetch_add(p, v, __ATOMIC_RELAXED, __HIP_MEMORY_SCOPE_AGENT); }
__device__ __forceinline__ unsigned xb_xcc_id() { return (unsigned)__builtin_amdgcn_s_getreg((3 << 11) | 20) & 0xFu; }
#define XB_SPIN(cond, bar) do { unsigned _sp = 0; while (cond) { __builtin_amdgcn_s_sleep(1); \
    if ((++_sp & 255u) == 0u) { if (xb_ld(&(bar)[XB_TMO])) break; if (_sp > XB_SPIN_CAP) { atomicAdd(&(bar)[XB_TMO], 1u); break; } } } } while (0)

struct XcdBarrier {
    unsigned* bar; unsigned x;
    volatile LAS unsigned* st;
};
__device__ __forceinline__ XcdBarrier xcd_barrier_post(unsigned* bar, volatile LAS unsigned* st) {
    XcdBarrier b; b.bar = bar; b.x = xb_xcc_id(); b.st = st;
    if (threadIdx.x == 0) (void)xb_add(&bar[XB_XCNT(b.x)], 1u);
    return b;
}
__device__ __forceinline__ void xcd_barrier_complete(unsigned* bar, unsigned x, unsigned& nloc, unsigned& nx) {
    const unsigned G = gridDim.x * gridDim.y * gridDim.z;
    unsigned sum, cnt, mine, sp = 0u;
    for (;;) {
        sum = 0u; cnt = 0u; mine = 0u;
#pragma unroll
        for (unsigned j = 0; j < 16; ++j) { const unsigned c = xb_ld(&bar[XB_XCNT(j)]); sum += c; cnt += (c > 0u) ? 1u : 0u; mine = (j == x) ? c : mine; }
        if (sum == G) break;
        __builtin_amdgcn_s_sleep(1);
        if ((++sp & 255u) == 0u) { if (xb_ld(&bar[XB_TMO])) break; if (sp > XB_SPIN_CAP) { atomicAdd(&bar[XB_TMO], 1u); break; } }
    }
    nloc = mine > 0u ? mine : 1u; nx = cnt > 0u ? cnt : 1u;
}

__device__ __forceinline__ void xcd_barrier(const XcdBarrier& b) {
    asm volatile("s_waitcnt vmcnt(0)" ::: "memory");
    __syncthreads();
    if (threadIdx.x == 0) {
        unsigned* bar = b.bar;
        __builtin_amdgcn_s_waitcnt(0);
        unsigned nloc = b.st[0], nx = b.st[1];
        if (nloc == 0u) { xcd_barrier_complete(bar, b.x, nloc, nx); b.st[0] = nloc; b.st[1] = nx; }
        const unsigned old = xb_add(&bar[XB_XSUB(b.x)], 1u);
        const unsigned gen = old / nloc;
        if (old + 1u == (gen + 1u) * nloc) {
            __builtin_amdgcn_fence(__ATOMIC_RELEASE, "agent");
            asm volatile("s_waitcnt vmcnt(0)" ::: "memory");
            const unsigned og = xb_add(&bar[XB_TOP], 1u);
            const unsigned tg = og / nx;
            if (og + 1u == (tg + 1u) * nx) xb_add(&bar[XB_TOPGEN], 1u);
            else XB_SPIN(xb_ld(&bar[XB_TOPGEN]) == tg, bar);
            __builtin_amdgcn_fence(__ATOMIC_ACQUIRE, "agent");
            xb_add(&bar[XB_XGEN(b.x)], 1u);
            asm volatile("s_waitcnt vmcnt(0)" ::: "memory");
        } else {
            XB_SPIN(xb_ld(&bar[XB_XGEN(b.x)]) == gen, bar);
            __builtin_amdgcn_fence(__ATOMIC_ACQUIRE, "agent");
            asm volatile("s_waitcnt vmcnt(0)" ::: "memory");
        }
    }
    __syncthreads();
}


__global__ void __launch_bounds__(512, 2) mk_fwd(Params p) {
    extern __shared__ __attribute__((aligned(16))) unsigned char lds_raw[];
    lds_u8* L = (lds_u8*)lds_raw;
    cg::grid_group grid = cg::this_grid();
    const int G = gridDim.x, bx = blockIdx.x;
    unsigned char* ws = p.ws;
    bf16_t* WinT = (bf16_t*)(ws + WS_WIN); bf16_t* WoutT = (bf16_t*)(ws + WS_WOUT); bf16_t* WguT = (bf16_t*)(ws + WS_WGU); bf16_t* WdT = (bf16_t*)(ws + WS_WD);
    bf16_t* WadaT = (bf16_t*)(ws + WS_ADA_CST); bf16_t* SC = (bf16_t*)(ws + WS_SC); float* MOD = (float*)(ws + WS_MOD);
    bf16_t* H = (bf16_t*)(ws + WS_H); bf16_t* PROJ = (bf16_t*)(ws + WS_PROJ); bf16_t* ACT = (bf16_t*)(ws + WS_PROJ); bf16_t* MIX = (bf16_t*)(ws + WS_MIX);
    LAS f32x4* red = (LAS f32x4*)(L + 131072);
    if (threadIdx.x < 16) ((LAS unsigned*)(L + 131072 + 8192))[threadIdx.x] = 0u;
    __syncthreads();
    XcdBarrier xb; xb.bar = (unsigned*)(ws + WS_BAR); xb.x = 0; xb.st = nullptr;
    if (!MULTI_LAUNCH) xb = xcd_barrier_post((unsigned*)(ws + WS_BAR), (volatile LAS unsigned*)(L + 131072 + 8192));
#define IN(k) (((PHASE_MASK >> (k)) & 1) && p.ph_lo <= (k) && (k) < p.ph_hi)
#define GBAR(k) do { if ((k) == 0) grid.sync(); else xcd_barrier(xb); } while (0)
#define PHASE(k) if (IN(k)) for (int rep_ = 0, nrep_ = (((REPEAT_MASK >> (k)) & 1) ? 2 : 1); rep_ < nrep_; ++rep_, ((rep_ < nrep_ || (k) + 1 < p.ph_hi) ? (void)[&]{ GBAR(k); }() : (void)0))

    PHASE(0) { phase_convert(p, L); }
    PHASE(1) {
        for (int u = bx; u < 384; u += G)
            sgemm_unit<8, 1, false>(red, SC, WadaT, D, 0, 9, u * 16, 0, [&](int r, int c, f32x4 a, f32x4) { if (r < 136) { const int col = u * 16 + c; *(f32x4*)(MOD + (size_t)r * NMOD + col) = a + *(const f32x4*)(p.in[8] + col); } }); }
    PHASE(2) { phase_norm<0>(p); }
    PHASE(3) {
        pg8::Gemm g{H, WinT, TP, NP, D}; pg8::StaticOrder S; S.init(TP, NP, G, bx); EpiProj E{PROJ};
        pg8::gemm_phase<EpiProj, pg8::StaticOrder>(L, g, S, E, nullptr);
        for (int u = bx; u < 192; u += G)
            sgemm_unit<8, 1, false>(red, H + (size_t)TP * D, WinT, D, 0, 8, u * 16, 0, [&](int r, int c, f32x4 a, f32x4) { E.small(TP + r, u * 16 + c, a); }); }
    PHASE(4) { for (int it = bx; it < 1024; it += G) { if (it < 512) mlstm_pass1(p, L, it); else sample_item(p, L, it - 512); } }
    PHASE(5) { mlstm_scan(p); for (int it = bx; it < 512; it += G) cmlp_item(p, L, it); }
    PHASE(6) { for (int it = bx; it < 512; it += G) mlstm_pass3(p, L, it); }
    PHASE(7) {
        pg8::Gemm g{MIX, WoutT, TP, D, D}; pg8::StaticOrder S; S.init(TP, D, G, bx); EpiRes E{p.in[0], MOD + 2048, p.out};
        pg8::gemm_phase<EpiRes, pg8::StaticOrder>(L, g, S, E, nullptr);
        for (int u = bx; u < 256; u += G) { const int ct = u >> 2, rg = u & 3;
            sgemm_unit<2, 4, false>(red, MIX + (size_t)TP * D, WoutT, D, rg * 2, 2, ct * 16, 0, [&](int r, int c, f32x4 a, f32x4) { const int col = ct * 16 + c;
                const f32x4 xv = *(const f32x4*)(p.in[1] + (size_t)r * D + col), gt = *(const f32x4*)(MOD + (size_t)(8 + r) * NMOD + 2048 + col); *(f32x4*)(p.out + (size_t)(TP + r) * D + col) = xv + gt * a; }); } }
    PHASE(8) { phase_norm<1>(p); }
    PHASE(9) {
        pg8::Gemm g{H, WguT, TP, 2 * DFF, D}; pg8::StaticOrder S; S.init(TP, 2 * DFF, G, bx); EpiSwi E{ACT};
        pg8::gemm_phase<EpiSwi, pg8::StaticOrder>(L, g, S, E, nullptr);
        for (int u = bx; u < 176; u += G) { const int br = (u >> 3) * 256 + (u & 7) * 16;
            sgemm_unit<8, 1, true>(red, H + (size_t)TP * D, WguT, D, 0, 8, br, br + 128, [&](int r, int c, f32x4 a, f32x4 b) { f32x4 v;
                for (int j = 0; j < 4; ++j) v[j] = a[j] * sigm(a[j]) * b[j];
                u32x2 w; w.x = cvt_pk_bf16(v[0], v[1]); w.y = cvt_pk_bf16(v[2], v[3]); *(u32x2*)(ACT + (size_t)(TP + r) * DFF + u * 16 + c) = w; }); } }
    PHASE(10) {
        pg8::Gemm g{ACT, WdT, TP, D, DFF}; pg8::StaticOrder S; S.init(TP, D, G, bx); EpiRes E{p.out, MOD + 5120, p.out};
        pg8::gemm_phase<EpiRes, pg8::StaticOrder>(L, g, S, E, nullptr);
        for (int u = bx; u < 256; u += G) { const int ct = u >> 2, rg = u & 3;
            sgemm_unit<2, 4, false>(red, ACT + (size_t)TP * DFF, WdT, DFF, rg * 2, 2, ct * 16, 0, [&](int r, int c, f32x4 a, f32x4) { const int col = ct * 16 + c;
                float* op = p.out + (size_t)(TP + r) * D + col; const f32x4 gt = *(const f32x4*)(MOD + (size_t)(8 + r) * NMOD + 5120 + col); *(f32x4*)op = *(const f32x4*)op + gt * a; }); } }
    PHASE(11) { phase_norm<2>(p); }
}

extern "C" void kernel_launch(void* const* d_in, const int* in_sizes, int n_in, void* d_out, int out_size, void* d_ws, size_t ws_size, hipStream_t stream) {
    static int grid = 0;
    if (grid == 0) {
        int dev = 0, cus = 0, per_cu = 0;
        (void)hipGetDevice(&dev); (void)hipDeviceGetAttribute(&cus, hipDeviceAttributeMultiprocessorCount, dev);
        if (hipFuncSetAttribute((const void*)mk_fwd, hipFuncAttributeMaxDynamicSharedMemorySize, LDS_BYTES) != hipSuccess) { fprintf(stderr, "kernel_launch: hipFuncSetAttribute failed\n"); grid = -1; return; }
        if (hipOccupancyMaxActiveBlocksPerMultiprocessor(&per_cu, (const void*)mk_fwd, 512, LDS_BYTES) != hipSuccess || per_cu < 1) { fprintf(stderr, "kernel_launch: occupancy query says %d\n", per_cu); per_cu = 1; }
        (void)hipGetLastError();
        grid = cus * per_cu;
        if (n_in != 22 || ws_size < WS_END) { fprintf(stderr, "kernel_launch: unexpected n_in %d / ws %zu\n", n_in, ws_size); grid = -1; return; }
    }
    if (grid < 0) return;
    Params p{};
    for (int i = 0; i < 22; ++i) p.in[i] = (const float*)d_in[i];
    p.out = (float*)d_out; p.ws = (unsigned char*)d_ws;
#if MULTI_LAUNCH
    for (int ph = 0; ph < N_PHASES; ++ph) { p.ph_lo = ph; p.ph_hi = ph + 1; for (int r = 0; r < (((HOST_REPEAT_MASK >> ph) & 1) ? 2 : 1); ++r) hipLaunchKernelGGL(mk_fwd, dim3(grid), dim3(512), LDS_BYTES, stream, p); }
#else
    (void)hipMemsetAsync((unsigned char*)d_ws + WS_BAR, 0, XCD_BAR_WORDS * 4, stream);
    p.ph_lo = 0; p.ph_hi = N_PHASES;
    void* args[] = {&p};
    hipError_t e = hipLaunchCooperativeKernel((const void*)mk_fwd, dim3(grid), dim3(512), args, LDS_BYTES, stream);
    if (e != hipSuccess) fprintf(stderr, "kernel_launch: cooperative launch failed: %s (grid %d)\n", hipGetErrorString(e), grid);
#endif
}
```

```cpp
#include <hip/hip_cooperative_groups.h>
#include <cstdio>
#include <hip/hip_runtime.h>
namespace pg8 {
#define PG8_LAS __attribute__((address_space(3)))
typedef unsigned short bf16_t;
typedef short bf16x8 __attribute__((ext_vector_type(8)));
typedef float f32x4 __attribute__((ext_vector_type(4)));
typedef unsigned u32x4 __attribute__((ext_vector_type(4)));
constexpr int BM = 256, BK = 64, HALF = 128, HTB = HALF * BK * 2  , STAGE_BYTES = 8 * HTB, NXCD = 8, WGM = 8;

__host__ __device__ __forceinline__ int lds_byte(int r, int c) { const int st = (r >> 4) * 2 + (c >> 5), rr = r & 15, cc = c & 31, ob = rr * 64 + cc * 2; return st * 1024 + (ob ^ (((ob >> 9) & 1) << 5)); }
__host__ __device__ __forceinline__ void stage_rc(int b, int& R, int& C) { const int st = b / 1024, sb = b % 1024, swz = sb ^ (((sb >> 9) & 1) << 5); R = (st >> 1) * 16 + swz / 64; C = (st & 1) * 32 + (swz % 64) / 2; }
__host__ __device__ __forceinline__ int perm32(int rho) { const int n = rho >> 4, i = rho & 15; return 8 * (i >> 2) + 4 * n + (i & 3); }

struct Unit { int pm, pn; };
struct Gemm { const bf16_t* A; const bf16_t* Bt; int M, N, K; };

struct StaticOrder {
    int nM, nN, nwg, G, c;
    __host__ __device__ void init(int M, int N, int G_, int c_) { nM = M / BM; nN = N / BM; nwg = nM * nN; G = G_; c = c_; }
    __host__ __device__ bool next(int i, Unit& u) const {
        const long L = (long)i * G + c; if (L >= nwg) return false;
        int wgid = (int)L; { const int q = nwg / NXCD, r = nwg % NXCD, xcd = wgid % NXCD, off = wgid / NXCD; wgid = (xcd < r ? xcd * (q + 1) : r * (q + 1) + (xcd - r) * q) + off; }
        const int nig = WGM * nN, gid = wgid / nig, fm = gid * WGM, gsz = (nM - fm) < WGM ? (nM - fm) : WGM;
        u.pm = fm + ((wgid % nig) % gsz); u.pn = (wgid % nig) / gsz; return true;
    }
    __device__ __forceinline__ void a_ready(const Unit&) const {}
    __device__ __forceinline__ void done(const Unit&) const {}
};
struct CountedOrder : StaticOrder {
    const unsigned* ready; unsigned need; unsigned* tmo;
    __device__ __forceinline__ void a_ready(const Unit& u) const {
        if (threadIdx.x < 64) {
            const unsigned long long t0 = __builtin_amdgcn_s_memrealtime(); unsigned polls = 0;
            while ((unsigned)__builtin_amdgcn_readfirstlane(__hip_atomic_load(ready + 64 * u.pm, __ATOMIC_RELAXED, __HIP_MEMORY_SCOPE_AGENT)) < need) {
                if ((++polls & 255u) == 0u && __builtin_amdgcn_readfirstlane(__hip_atomic_load(tmo, __ATOMIC_RELAXED, __HIP_MEMORY_SCOPE_AGENT)) != 0u) break;
                if (__builtin_amdgcn_s_memrealtime() - t0 > 2000000ull) {
                    if (threadIdx.x == 0) { unsigned expect = 0u; __hip_atomic_compare_exchange_strong(tmo + 1, &expect, 0x600u | (unsigned)(u.pm & 0xff), __ATOMIC_RELAXED, __ATOMIC_RELAXED, __HIP_MEMORY_SCOPE_AGENT); __hip_atomic_store(tmo, 1u, __ATOMIC_RELAXED, __HIP_MEMORY_SCOPE_AGENT); }
                    break; }
                __builtin_amdgcn_s_sleep(2); }
            __builtin_amdgcn_fence(__ATOMIC_ACQUIRE, "agent");
            asm volatile("s_waitcnt vmcnt(0)" ::: "memory");
        }
#if !defined(BROKEN_HOOK_NO_BARRIER)
        asm volatile("" ::: "memory"); __builtin_amdgcn_s_barrier(); asm volatile("" ::: "memory");
#endif
    }
};

template <class Epi, class Sched, bool STAMP = false>
__device__ __forceinline__ void gemm_phase(PG8_LAS unsigned char* lds, const Gemm g, const Sched& S, const Epi& E, unsigned long long* stamps) {
    const int tid = threadIdx.x, wid = __builtin_amdgcn_readfirstlane(tid >> 6), lane = tid & 63, wr = wid >> 2, wc = wid & 3, fr = lane & 15, fq = lane >> 4;
    const int K = g.K, nt = K / BK;
    int ts_lo = 0, ts_hi = 0, nts = 0; const unsigned long long rt_entry = STAMP ? (unsigned long long)wall_clock64() : 0ull;
#define PG8_STAMP() do { if (STAMP && wid == 0 && nts < 64) { const unsigned long long _c = (unsigned long long)clock64(); \
        ts_lo = (lane == nts) ? (int)(unsigned)_c : ts_lo; ts_hi = (lane == nts) ? (int)(unsigned)(_c >> 32) : ts_hi; ++nts; } } while (0)
    PG8_STAMP();
    unsigned voffA[2], voffB[2];
#pragma unroll
    for (int i = 0; i < 2; ++i) { int R, C; stage_rc(tid * 16 + i * 8192, R, C); const int Rb = Epi::PERM ? ((R & ~31) + perm32(R & 31)) : R;
        voffA[i] = (unsigned)(R * K + C) * 2u; voffB[i] = (unsigned)(Rb * K + C) * 2u; }
    const size_t kstep = (size_t)(BK * 2);
    const size_t hstep = (size_t)HALF * K * 2;
    const size_t tstep = 2 * hstep;
    const unsigned ldsw = (unsigned)wid * 1024u;
    const int aoff = lds_byte(wr * 64 + fr, fq * 8), boff = lds_byte(wc * 32 + fr, fq * 8);
#define PG8_SA(b, h) (((b) * 2 + (h)) * HTB)
#define PG8_SB(b, h) ((4 + (b) * 2 + (h)) * HTB)
#define PG8_STAGE(bufoff, gbase, voff) do { _Pragma("unroll") for (int _i = 0; _i < 2; ++_i) \
        __builtin_amdgcn_global_load_lds((const unsigned*)((const char*)(gbase) + (voff)[_i]), (PG8_LAS unsigned*)(lds + (bufoff) + ldsw + _i * 8192), 16, 0, 0); } while (0)
#define PG8_LDA(dst, b, h) do { _Pragma("unroll") for (int m = 0; m < 4; ++m) _Pragma("unroll") for (int k = 0; k < 2; ++k) dst[m][k] = *(const PG8_LAS bf16x8*)(lds + PG8_SA(b, h) + aoff + m * 2048 + k * 1024); } while (0)
#define PG8_LDB(dst, b, h) do { _Pragma("unroll") for (int n = 0; n < 2; ++n) _Pragma("unroll") for (int k = 0; k < 2; ++k) dst[n][k] = *(const PG8_LAS bf16x8*)(lds + PG8_SB(b, h) + boff + n * 2048 + k * 1024); } while (0)
#define PG8_MMA(ai, bj, At, Bt) do { __builtin_amdgcn_s_setprio(1); _Pragma("unroll") for (int m = 0; m < 4; ++m) _Pragma("unroll") for (int n = 0; n < 2; ++n) _Pragma("unroll") for (int k = 0; k < 2; ++k) \
        acc[ai][bj][m][n] = __builtin_amdgcn_mfma_f32_16x16x32_bf16(Bt[n][k], At[m][k], acc[ai][bj][m][n], 0, 0, 0); __builtin_amdgcn_s_setprio(0); } while (0)
#define PG8_WAIT_V(n) asm volatile("s_waitcnt vmcnt(" #n ")" ::: "memory")
#define PG8_WAIT_L(n) asm volatile("s_waitcnt lgkmcnt(" #n ")" ::: "memory")
#define PG8_BAR __builtin_amdgcn_s_barrier()
#define PG8_SCHED __builtin_amdgcn_sched_barrier(0)
    Unit cur, nxt; int ui = 0;
    if (!S.next(0, cur)) return;
    f32x4 acc[2][2][4][2];
#pragma unroll
    for (int a = 0; a < 2; ++a)
#pragma unroll
        for (int b = 0; b < 2; ++b)
#pragma unroll
            for (int m = 0; m < 4; ++m)
#pragma unroll
                for (int n = 0; n < 2; ++n) acc[a][b][m][n] = (f32x4){0.f, 0.f, 0.f, 0.f};
    bf16x8 At[4][2], B0[2][2], B1[2][2];
    const char* cA = (const char*)g.A + (size_t)cur.pm * tstep; const char* cB = (const char*)g.Bt + (size_t)cur.pn * tstep;
    S.a_ready(cur);
    PG8_STAGE(PG8_SB(0, 0), cB, voffB); PG8_STAGE(PG8_SA(0, 0), cA, voffA); PG8_STAGE(PG8_SB(0, 1), cB + hstep, voffB); PG8_STAGE(PG8_SA(0, 1), cA + hstep, voffA);
    if (wr == 1) PG8_BAR;
    PG8_WAIT_V(4); PG8_BAR;
    PG8_STAGE(PG8_SB(1, 0), cB + kstep, voffB); PG8_STAGE(PG8_SA(1, 0), cA + kstep, voffA); PG8_STAGE(PG8_SB(1, 1), cB + hstep + kstep, voffB);
    PG8_WAIT_V(6); PG8_BAR;
    PG8_STAMP();
    for (;;) {
        const bool has_next = S.next(ui + 1, nxt);
        const char* nA = has_next ? (const char*)g.A + (size_t)nxt.pm * tstep : cA; const char* nB = has_next ? (const char*)g.Bt + (size_t)nxt.pn * tstep : cB;
        for (int t = 0; t < nt; t += 2) {
            const bool last = (t == nt - 2);
            const char* a1 = cA + (size_t)(t + 1) * kstep;
            const char* a2 = last ? nA : cA + (size_t)(t + 2) * kstep; const char* b2 = last ? nB : cB + (size_t)(t + 2) * kstep;
            const char* a3 = a2 + kstep; const char* b3 = b2 + kstep;
            if (last && has_next) S.a_ready(nxt);
            PG8_LDB(B0, 0, 0); PG8_SCHED; PG8_LDA(At, 0, 0); PG8_STAGE(PG8_SA(1, 1), a1 + hstep, voffA);
            PG8_WAIT_L(8); PG8_BAR; PG8_WAIT_L(0); PG8_MMA(0, 0, At, B0); PG8_BAR; PG8_SCHED;
            PG8_LDB(B1, 0, 1); PG8_STAGE(PG8_SB(0, 0), b2, voffB);
            PG8_BAR; PG8_WAIT_L(0); PG8_MMA(0, 1, At, B1); PG8_BAR;
            PG8_LDA(At, 0, 1); PG8_STAGE(PG8_SA(0, 0), a2, voffA);
            PG8_BAR; PG8_WAIT_L(0); PG8_MMA(1, 0, At, B0); PG8_BAR; PG8_SCHED;
            PG8_STAGE(PG8_SB(0, 1), b2 + hstep, voffB);
            PG8_WAIT_V(6); PG8_BAR; PG8_MMA(1, 1, At, B1); PG8_BAR;
            PG8_LDB(B0, 1, 0); PG8_SCHED; PG8_LDA(At, 1, 0); PG8_STAGE(PG8_SA(0, 1), a2 + hstep, voffA);
            PG8_WAIT_L(8); PG8_BAR; PG8_WAIT_L(0); PG8_MMA(0, 0, At, B0); PG8_BAR; PG8_SCHED;
            PG8_LDB(B1, 1, 1); PG8_STAGE(PG8_SB(1, 0), b3, voffB);
            PG8_BAR; PG8_WAIT_L(0); PG8_MMA(0, 1, At, B1); PG8_BAR;
            PG8_LDA(At, 1, 1); PG8_STAGE(PG8_SA(1, 0), a3, voffA);
            PG8_BAR; PG8_WAIT_L(0); PG8_MMA(1, 0, At, B0); PG8_BAR; PG8_SCHED;
            PG8_STAGE(PG8_SB(1, 1), b3 + hstep, voffB);
            PG8_WAIT_V(6); PG8_BAR; PG8_MMA(1, 1, At, B1); PG8_BAR;
        }
        PG8_STAMP();
        if constexpr (!Epi::AFTER_DRAIN) { E(acc, cur, wr, wc, fr, fq); S.done(cur); }
        PG8_STAMP();
        if (!has_next) break;
#pragma unroll
        for (int a = 0; a < 2; ++a)
#pragma unroll
            for (int b = 0; b < 2; ++b)
#pragma unroll
                for (int m = 0; m < 4; ++m)
#pragma unroll
                    for (int n = 0; n < 2; ++n) acc[a][b][m][n] = (f32x4){0.f, 0.f, 0.f, 0.f};
        cur = nxt; cA = nA; cB = nB; ++ui;
    }
    PG8_WAIT_V(0);
    if (wr == 0) PG8_BAR;
    PG8_BAR;
    if constexpr (Epi::AFTER_DRAIN) { E.fused(acc, cur, wr, wc, fr, fq, lds, wid, lane); S.done(cur); }
    PG8_STAMP();
    if (STAMP && wid == 0) { stamps[lane] = lane < nts ? (((unsigned long long)(unsigned)ts_hi << 32) | (unsigned)ts_lo) : 0ull;
        if (lane == 62) stamps[62] = rt_entry; if (lane == 63) stamps[63] = (unsigned long long)wall_clock64(); }
#undef PG8_STAMP
#undef PG8_SA
#undef PG8_SB
#undef PG8_STAGE
#undef PG8_LDA
#undef PG8_LDB
#undef PG8_MMA
#undef PG8_WAIT_V
#undef PG8_WAIT_L
#undef PG8_BAR
#undef PG8_SCHED
}
}
namespace cg = cooperative_groups;
using pg8::Unit;
#define LAS __attribute__((address_space(3)))
typedef LAS unsigned char lds_u8;
typedef unsigned short bf16_t;
typedef short bf16x8 __attribute__((ext_vector_type(8)));
typedef float f32x4 __attribute__((ext_vector_type(4)));
typedef unsigned u32x4 __attribute__((ext_vector_type(4)));
typedef unsigned u32x2 __attribute__((ext_vector_type(2)));

constexpr int D = 1024, TP = 16384, TS = 128, ROWS = TP + TS, NIN = 3080, NP = 3072, DFF = 2816, NMOD = 6144;
constexpr float LOG2E = 1.4426950408889634f;
constexpr int LDS_BYTES = 131072 + 8192 + 64;
constexpr size_t WS_WIN = 0, WS_WOUT = 6291456, WS_WGU = 8388608, WS_WD = 19922944, WS_ADA_CST = 25690112, WS_SC = 42467328,
    WS_MOD = 42762240, WS_GATES = 46104576, WS_H = 46632960, WS_PROJ = 80711680, WS_MIX = 182947840, WS_VEC = 217026560;
constexpr size_t WS_BV = WS_VEC, WS_AV = WS_VEC + 262144, WS_PM = WS_VEC + 2 * 262144, WS_NLOC = WS_VEC + 3 * 262144, WS_NST = WS_VEC + 4 * 262144,
    WS_BC = WS_VEC + 5 * 262144, WS_PC = WS_BC + 2048, WS_MST = WS_PC + 2048, WS_BAR = WS_MST + 2048, WS_GW = WS_BAR + 2 * 16384, WS_END = WS_GW + 32768;
constexpr size_t O_Y = 0, O_CP = 16908288, O_NP = 17432576, O_MP = 17436672, O_CS = 17436704, O_NS = 25825312, O_MS = 25890848, O_VS = 25891360;

struct Params { const float* in[22]; float* out; unsigned char* ws; int ph_lo, ph_hi, lo2, hi2; };

__device__ __forceinline__ unsigned cvt_pk_bf16(float lo, float hi) { unsigned r; asm("v_cvt_pk_bf16_f32 %0, %1, %2" : "=v"(r) : "v"(lo), "v"(hi)); return r; }
__device__ __forceinline__ float bflo(unsigned w) { return __uint_as_float(w << 16); }
__device__ __forceinline__ float bfhi(unsigned w) { return __uint_as_float(w & 0xffff0000u); }
__device__ __forceinline__ float fexp(float x) { return __builtin_amdgcn_exp2f(x * LOG2E); }
__device__ __forceinline__ float sigm(float x) { return __builtin_amdgcn_rcpf(1.0f + fexp(-x)); }
__device__ __forceinline__ float gelu_t(float x) { return x * sigm(1.5957691216057308f * x * (1.0f + 0.044715f * x * x)); }
__device__ __forceinline__ float logsig(float f) { return fminf(f, 0.f) - log1pf(expf(-fabsf(f))); }
__device__ __forceinline__ float wsum(float v) { for (int o = 32; o >= 1; o >>= 1) v += __shfl_xor(v, o); return v; }
__device__ __forceinline__ int mod_row(int row) { return row < TP ? (row >> 11) : (8 + row - TP); }

__device__ __forceinline__ f32x4 proj_act(int seg, f32x4 v) {
    if (seg == 0) { v *= 0.08838834764831845f; }
    else if (seg == 3) { for (int j = 0; j < 4; ++j) v[j] = sigm(v[j]); }
    else if (seg >= 4) { for (int j = 0; j < 4; ++j) v[j] = gelu_t(v[j]); }
    return v;
}
struct EpiProj {
    static constexpr bool PERM = false, AFTER_DRAIN = false;
    bf16_t* P;
    __device__ __forceinline__ void operator()(const f32x4 (&acc)[2][2][4][2], const Unit& u, int wr, int wc, int fr, int fq) const {
        const int seg = u.pn >> 1; const int row0 = u.pm * 256 + wr * 64 + fr, col0 = u.pn * 256 + wc * 32 + 4 * fq;
#pragma unroll
        for (int ai = 0; ai < 2; ++ai)
#pragma unroll
            for (int m = 0; m < 4; ++m) { bf16_t* rowp = P + (size_t)(row0 + ai * 128 + m * 16) * NP + col0;
#pragma unroll
                for (int bj = 0; bj < 2; ++bj)
#pragma unroll
                    for (int n = 0; n < 2; ++n) { const f32x4 v = proj_act(seg, acc[ai][bj][m][n]); u32x2 w; w.x = cvt_pk_bf16(v[0], v[1]); w.y = cvt_pk_bf16(v[2], v[3]);
                        *(u32x2*)(rowp + bj * 128 + n * 16) = w; } }
    }
    __device__ __forceinline__ void small(int row, int col, f32x4 v) const { v = proj_act(col >> 9, v); u32x2 w; w.x = cvt_pk_bf16(v[0], v[1]); w.y = cvt_pk_bf16(v[2], v[3]); *(u32x2*)(P + (size_t)row * NP + col) = w; }
};
struct EpiRes {
    static constexpr bool PERM = false, AFTER_DRAIN = false;
    const float* x; const float* gate; float* o;
    __device__ __forceinline__ void operator()(const f32x4 (&acc)[2][2][4][2], const Unit& u, int wr, int wc, int fr, int fq) const {
        const int row0 = u.pm * 256 + wr * 64 + fr, col0 = u.pn * 256 + wc * 32 + 4 * fq; const float* gp = gate + (size_t)(u.pm >> 3) * NMOD + col0;
        f32x4 g[2][2];
#pragma unroll
        for (int bj = 0; bj < 2; ++bj)
#pragma unroll
            for (int n = 0; n < 2; ++n) g[bj][n] = *(const f32x4*)(gp + bj * 128 + n * 16);
        f32x4 xv[2][2][2];
#pragma unroll
        for (int bj = 0; bj < 2; ++bj)
#pragma unroll
            for (int n = 0; n < 2; ++n) xv[0][bj][n] = *(const f32x4*)(x + (size_t)row0 * D + col0 + bj * 128 + n * 16);
#pragma unroll
        for (int gi = 0; gi < 8; ++gi) { const int ai = gi >> 2, m = gi & 3; const size_t off = (size_t)(row0 + ai * 128 + m * 16) * D + col0;
            if (gi < 7) { const size_t offn = (size_t)(row0 + ((gi + 1) >> 2) * 128 + ((gi + 1) & 3) * 16) * D + col0;
#pragma unroll
                for (int bj = 0; bj < 2; ++bj)
#pragma unroll
                    for (int n = 0; n < 2; ++n) xv[(gi + 1) & 1][bj][n] = *(const f32x4*)(x + offn + bj * 128 + n * 16); }
#pragma unroll
            for (int bj = 0; bj < 2; ++bj)
#pragma unroll
                for (int n = 0; n < 2; ++n) *(f32x4*)(o + off + bj * 128 + n * 16) = xv[gi & 1][bj][n] + g[bj][n] * acc[ai][bj][m][n]; }
    }
};
struct EpiSwi {
    static constexpr bool PERM = false, AFTER_DRAIN = false;
    bf16_t* A;
    __device__ __forceinline__ void operator()(const f32x4 (&acc)[2][2][4][2], const Unit& u, int wr, int wc, int fr, int fq) const {
        const int row0 = u.pm * 256 + wr * 64 + fr, col0 = u.pn * 128 + wc * 32 + 4 * fq;
#pragma unroll
        for (int ai = 0; ai < 2; ++ai)
#pragma unroll
            for (int m = 0; m < 4; ++m) { bf16_t* rowp = A + (size_t)(row0 + ai * 128 + m * 16) * DFF + col0;
#pragma unroll
                for (int n = 0; n < 2; ++n) { const f32x4 a = acc[ai][0][m][n], b = acc[ai][1][m][n]; f32x4 r;
#pragma unroll
                    for (int j = 0; j < 4; ++j) r[j] = a[j] * sigm(a[j]) * b[j];
                    u32x2 w; w.x = cvt_pk_bf16(r[0], r[1]); w.y = cvt_pk_bf16(r[2], r[3]); *(u32x2*)(rowp + n * 16) = w; } }
    }
};

template <int RT, int KS, bool DUAL, class F, bool CW = false>
__device__ __forceinline__ void sgemm_unit(LAS f32x4* red, const bf16_t* A, const bf16_t* Bt, int K, int rt0, int nrt, int brow0, int brow_dual, const F& f) {
    const int tid = threadIdx.x, wid = tid >> 6, lane = tid & 63, fr = lane & 15, fq = lane >> 4, rtl = CW ? 0 : wid % RT, ks = CW ? 0 : wid / RT;
    if (CW) { brow0 += 16 * wid; brow_dual += 16 * wid; }
    const int kb = ks * (K / KS), ke = kb + K / KS;
    for (int rt = rt0 + rtl; rt < rt0 + nrt; rt += (CW ? 1024 : RT)) {
        f32x4 acc = {0.f, 0.f, 0.f, 0.f}, acc2 = {0.f, 0.f, 0.f, 0.f};
        const bf16_t* ap = A + (size_t)(rt * 16 + fr) * K + fq * 8; const bf16_t* bp = Bt + (size_t)(brow0 + fr) * K + fq * 8; const bf16_t* bp2 = Bt + (size_t)(brow_dual + fr) * K + fq * 8;
#pragma unroll 8
        for (int k = kb; k < ke; k += 32) {
            const bf16x8 a = *(const bf16x8*)(ap + k), b = *(const bf16x8*)(bp + k);
            acc = __builtin_amdgcn_mfma_f32_16x16x32_bf16(b, a, acc, 0, 0, 0);
            if (DUAL) { const bf16x8 b2 = *(const bf16x8*)(bp2 + k); acc2 = __builtin_amdgcn_mfma_f32_16x16x32_bf16(b2, a, acc2, 0, 0, 0); }
        }
        if (KS > 1) {
            red[wid * 64 + lane] = acc; __syncthreads();
            if (ks == 0) { for (int s = 1; s < KS; ++s) acc += red[(rtl + RT * s) * 64 + lane]; }
            __syncthreads();
            if (ks != 0) continue;
        }
        f(rt * 16 + fr, 4 * fq + (CW ? 16 * wid : 0), acc, acc2);
    }
}
__device__ __forceinline__ void conv_unit(LAS float* T, const float* src, int ld_src, int k0, int c0, int c1, int c2, int c3, bf16_t* dst, int ldd, int n0) {
    const int tid = threadIdx.x; const int l16 = tid & 15, kr = tid >> 4; const int cb[4] = {c0, c1, c2, c3};
    f32x4 v[4][2];
#pragma unroll
    for (int sb = 0; sb < 4; ++sb)
#pragma unroll
        for (int ps = 0; ps < 2; ++ps) v[sb][ps] = __builtin_nontemporal_load((const f32x4*)(src + (size_t)(k0 + kr + 32 * ps) * ld_src + cb[sb] + 4 * l16));
#pragma unroll
    for (int sb = 0; sb < 4; ++sb)
#pragma unroll
        for (int ps = 0; ps < 2; ++ps)
#pragma unroll
            for (int i = 0; i < 4; ++i) T[sb * 4160 + (kr + 32 * ps) * 65 + 4 * l16 + i] = v[sb][ps][i];
    __syncthreads();
    const int kg = tid & 7, n = tid >> 3;
#pragma unroll
    for (int sb = 0; sb < 4; ++sb) { float x[8];
#pragma unroll
        for (int i = 0; i < 8; ++i) x[i] = T[sb * 4160 + (8 * kg + i) * 65 + n];
        u32x4 w; w.x = cvt_pk_bf16(x[0], x[1]); w.y = cvt_pk_bf16(x[2], x[3]); w.z = cvt_pk_bf16(x[4], x[5]); w.w = cvt_pk_bf16(x[6], x[7]);
        *(u32x4*)(dst + (size_t)(n0 + 64 * sb + n) * ldd + k0 + 8 * kg) = w; }
    __syncthreads();
}
__device__ void phase_convert(const Params& p, lds_u8* L) {
    LAS float* T = (LAS float*)L; unsigned char* ws = p.ws;
    const int NU = 1168 + 72 + 4;
    for (int u = blockIdx.x; u < NU; u += gridDim.x) {
        if (u < 384) { const int kb = u / 24, nb = u % 24, c = nb * 256; conv_unit(T, p.in[7], NMOD, kb * 64, c, c + 64, c + 128, c + 192, (bf16_t*)(ws + WS_ADA_CST), D, nb * 256); }
        else if (u < 576) { const int v = u - 384, kb = v / 12, nb = v % 12, c = nb * 256 + (nb >= 8 ? 8 : 0); conv_unit(T, p.in[10], NIN, kb * 64, c, c + 64, c + 128, c + 192, (bf16_t*)(ws + WS_WIN), D, nb * 256); }
        else if (u < 640) { const int v = u - 576, kb = v / 4, nb = v % 4, c = nb * 256; conv_unit(T, p.in[17], D, kb * 64, c, c + 64, c + 128, c + 192, (bf16_t*)(ws + WS_WOUT), D, nb * 256); }
        else if (u < 992) { const int v = u - 640, kb = v / 22, nb = v % 22, c = nb * 128; conv_unit(T, p.in[19], 2 * DFF, kb * 64, c, c + 64, DFF + c, DFF + c + 64, (bf16_t*)(ws + WS_WGU), D, nb * 256); }
        else if (u < 1168) { const int v = u - 992, kb = v / 4, nb = v % 4, c = nb * 256; conv_unit(T, p.in[20], D, kb * 64, c, c + 64, c + 128, c + 192, (bf16_t*)(ws + WS_WD), DFF, nb * 256); }
        else if (u >= 1168 + 72) { const int k = (u - 1240) * 256 + (threadIdx.x >> 1), hf = threadIdx.x & 1;
            const f32x4 w = *(const f32x4*)(p.in[10] + (size_t)k * NIN + 2048 + 4 * hf); float* gw = (float*)(ws + WS_GW);
#pragma unroll
            for (int i = 0; i < 4; ++i) gw[(4 * hf + i) * 1024 + k] = w[i]; }
        else { const int v = u - 1168; const int idx = v * 512 + threadIdx.x;
            const int r = idx >> 8, c = (idx & 255) * 4; f32x4 x = {0.f, 0.f, 0.f, 0.f};
            if (r < 8) x = *(const f32x4*)(p.in[2] + r * D + c); else if (r < 136) x = *(const f32x4*)(p.in[3] + (r - 8) * D + c);
            u32x2 w; w.x = cvt_pk_bf16(x[0] * sigm(x[0]), x[1] * sigm(x[1])); w.y = cvt_pk_bf16(x[2] * sigm(x[2]), x[3] * sigm(x[3]));
            *(u32x2*)((bf16_t*)(ws + WS_SC) + r * D + c) = w; }
    }
}

template <int MODE> __device__ void phase_norm(const Params& p) {
    const int lane = threadIdx.x & 63, gw = blockIdx.x * 8 + (threadIdx.x >> 6), nW = gridDim.x * 8;
    const float* mod = (const float*)(p.ws + WS_MOD); bf16_t* H = (bf16_t*)(p.ws + WS_H); float* gates = (float*)(p.ws + WS_GATES);
    const float* gain = MODE == 0 ? p.in[9] : (MODE == 1 ? p.in[18] : p.in[21]);
    f32x4 gv[4];
#pragma unroll
    for (int j = 0; j < 4; ++j) gv[j] = *(const f32x4*)(gain + 4 * lane + 256 * j);
    f32x4 wg[4][4][2];
    if (MODE == 0) {
#pragma unroll
        for (int j = 0; j < 4; ++j)
#pragma unroll
            for (int i = 0; i < 4; ++i) { wg[j][i][0] = (f32x4){0.f, 0.f, 0.f, 0.f}; wg[j][i][1] = wg[j][i][0]; }
        const float* gw = (const float*)(p.ws + WS_GW);
#pragma unroll
        for (int j = 0; j < 4; ++j)
#pragma unroll
            for (int g = 0; g < 8; ++g) { const f32x4 w = *(const f32x4*)(gw + g * 1024 + 4 * lane + 256 * j);
#pragma unroll
                for (int i = 0; i < 4; ++i) wg[j][i][g >> 2][g & 3] = w[i]; }
    }
    for (int r0 = gw; r0 < ROWS; r0 += 2 * nW) {
        const int r1 = r0 + nW; const bool has1 = r1 < ROWS; const int rr[2] = {r0, has1 ? r1 : r0};
        f32x4 xv[2][4]; float ss[2] = {0.f, 0.f};
#pragma unroll
        for (int q = 0; q < 2; ++q) { const int r = rr[q]; const float* src = MODE == 0 ? (r < TP ? p.in[0] + (size_t)r * D : p.in[1] + (size_t)(r - TP) * D) : p.out + (size_t)r * D;
#pragma unroll
            for (int j = 0; j < 4; ++j) xv[q][j] = *(const f32x4*)(src + 4 * lane + 256 * j); }
#pragma unroll
        for (int q = 0; q < 2; ++q) {
#pragma unroll
            for (int j = 0; j < 4; ++j) ss[q] += xv[q][j][0] * xv[q][j][0] + xv[q][j][1] * xv[q][j][1] + xv[q][j][2] * xv[q][j][2] + xv[q][j][3] * xv[q][j][3];
            ss[q] = wsum(ss[q]); }
#pragma unroll
        for (int q = 0; q < 2; ++q) { if (q == 1 && !has1) break;
            const int r = rr[q]; const float rstd = 1.0f / sqrtf(ss[q] * (1.0f / 1024.0f) + 1e-6f);
            if (MODE == 2) {
#pragma unroll
                for (int j = 0; j < 4; ++j) *(f32x4*)(p.out + (size_t)r * D + 4 * lane + 256 * j) = xv[q][j] * rstd * gv[j];
            } else {
                const float* mp = mod + (size_t)mod_row(r) * NMOD + (MODE == 0 ? 0 : 3072);
                f32x4 ga = {0.f, 0.f, 0.f, 0.f}, gb = {0.f, 0.f, 0.f, 0.f};
#pragma unroll
                for (int j = 0; j < 4; ++j) { const f32x4 sh = *(const f32x4*)(mp + 4 * lane + 256 * j), sc = *(const f32x4*)(mp + 1024 + 4 * lane + 256 * j);
                    const f32x4 h = xv[q][j] * rstd * gv[j] * (1.0f + sc) + sh;
                    u32x2 w; w.x = cvt_pk_bf16(h[0], h[1]); w.y = cvt_pk_bf16(h[2], h[3]); *(u32x2*)(H + (size_t)r * D + 4 * lane + 256 * j) = w;
                    if (MODE == 0) {
#pragma unroll
                        for (int i = 0; i < 4; ++i) { ga += h[i] * wg[j][i][0]; gb += h[i] * wg[j][i][1]; } } }
                if (MODE == 0) {
#pragma unroll
                    for (int i = 0; i < 4; ++i) { ga[i] = wsum(ga[i]); gb[i] = wsum(gb[i]); }
                    if (lane == 0) { const f32x4 b0 = *(const f32x4*)(p.in[11]), b1 = *(const f32x4*)(p.in[11] + 4); *(f32x4*)(gates + (size_t)r * 8) = ga + b0; *(f32x4*)(gates + (size_t)r * 8 + 4) = gb + b1; }
                }
            }
        }
    }
}

__device__ __forceinline__ int t128(int n, int k8) { return n * 256 + ((k8 ^ ((n ^ (n >> 3)) & 15)) << 4); }
__device__ __forceinline__ void stage_nat(lds_u8* T, const bf16_t* src, int ld) {
#pragma unroll
    for (int i = 0; i < 4; ++i) { const int g = threadIdx.x + 512 * i, n = g >> 4, k8 = g & 15; *(LAS u32x4*)(T + t128(n, k8)) = *(const u32x4*)(src + (size_t)n * ld + k8 * 8); }
}
template <class F> __device__ __forceinline__ void stage_T(lds_u8* T, const bf16_t* src, int ld, const F& xf) {
    const int rg = threadIdx.x >> 4, cg = threadIdx.x & 15; u32x4 r[4];
#pragma unroll
    for (int j = 0; j < 4; ++j) r[j] = *(const u32x4*)(src + (size_t)(4 * rg + j) * ld + 8 * cg);
#pragma unroll
    for (int i = 0; i < 8; ++i) { float v[4];
#pragma unroll
        for (int j = 0; j < 4; ++j) { const unsigned w = r[j][i >> 1]; v[j] = xf(4 * rg + j, 8 * cg + i, (i & 1) ? bfhi(w) : bflo(w)); }
        u32x2 o; o.x = cvt_pk_bf16(v[0], v[1]); o.y = cvt_pk_bf16(v[2], v[3]);
        const int n = 8 * cg + i; *(LAS u32x2*)(T + n * 256 + ((((rg >> 1)) ^ ((n ^ (n >> 3)) & 15)) << 4) + (rg & 1) * 8) = o; }
}
__device__ __forceinline__ void mm16(f32x4 (&acc)[8], const lds_u8* A, int arow0, const lds_u8* B, int fr, int fq) {
#pragma unroll 1
    for (int ks = 0; ks < 4; ++ks) { const bf16x8 a = *(const LAS bf16x8*)(A + t128(arow0 + fr, 4 * ks + fq));
#pragma unroll
        for (int n = 0; n < 8; ++n) { const bf16x8 b = *(const LAS bf16x8*)(B + t128(16 * n + fr, 4 * ks + fq)); acc[n] = __builtin_amdgcn_mfma_f32_16x16x32_bf16(b, a, acc[n], 0, 0, 0); } }
}
#define T_(i) (L + (i) * 32768)
#define SMF ((LAS float*)(L + 131072))

__device__ void mlstm_pass1(const Params& p, lds_u8* L, int item) {
    const int tid = threadIdx.x, wid = tid >> 6, lane = tid & 63, fr = lane & 15, fq = lane >> 4;
    const int bh = item >> 4, c = item & 15, b = bh >> 2, h = bh & 3, row0 = b * 2048 + c * 128;
    const bf16_t* P = (const bf16_t*)(p.ws + WS_PROJ) + (size_t)row0 * NP; const float* G = (const float*)(p.ws + WS_GATES) + (size_t)row0 * 8;
    LAS float* av = SMF; LAS float* wgv = SMF + 128;
    if (wid == 0) {
        const int t0 = 2 * lane; const float i0 = G[t0 * 8 + h], i1 = G[(t0 + 1) * 8 + h], lf0 = logsig(G[t0 * 8 + 4 + h]), lf1 = logsig(G[(t0 + 1) * 8 + 4 + h]);
        float s = lf0 + lf1;
        for (int o = 1; o < 64; o <<= 1) { const float t = __shfl_up(s, o); if (lane >= o) s += t; }
        const float b1 = s, b0 = s - lf1, a0 = i0 - b0, a1 = i1 - b1;
        float q = fmaxf(a0, a1);
        for (int o = 1; o < 64; o <<= 1) { const float t = __shfl_up(q, o); if (lane >= o) q = fmaxf(q, t); }
        float ex = __shfl_up(q, 1); if (lane == 0) ex = -INFINITY;
        const float pm0 = fmaxf(ex, a0), pm1 = q;
        float* bv_g = (float*)(p.ws + WS_BV) + item * 128; float* av_g = (float*)(p.ws + WS_AV) + item * 128; float* pm_g = (float*)(p.ws + WS_PM) + item * 128;
        bv_g[t0] = b0; bv_g[t0 + 1] = b1; av_g[t0] = a0; av_g[t0 + 1] = a1; pm_g[t0] = pm0; pm_g[t0 + 1] = pm1;
        const float PC = __shfl(q, 63);
        av[t0] = a0; av[t0 + 1] = a1; wgv[t0] = fexp(a0 - PC); wgv[t0 + 1] = fexp(a1 - PC);
        if (lane == 63) { ((float*)(p.ws + WS_BC))[item] = b1; ((float*)(p.ws + WS_PC))[item] = q; }
    }
    __syncthreads();
    stage_T(T_(2), P + 1024 + h * 128, NP, [&](int s, int, float v) { return v * wgv[s]; });
    stage_T(T_(1), P + 512 + h * 128, NP, [&](int, int, float v) { return v; });
    __syncthreads();
    f32x4 acc[8];
#pragma unroll
    for (int n = 0; n < 8; ++n) acc[n] = (f32x4){0.f, 0.f, 0.f, 0.f};
    mm16(acc, T_(2), 16 * wid, T_(1), fr, fq);
    float* cl = (float*)(p.ws + WS_H) + (size_t)item * 16384 + (16 * wid + fr) * 128 + 4 * fq;
#pragma unroll
    for (int n = 0; n < 8; ++n) *(f32x4*)(cl + 16 * n) = acc[n];
    { const int d = tid >> 2, q4 = tid & 3; float s = 0.f;
#pragma unroll
        for (int g = 0; g < 4; ++g) { const u32x4 w = *(const LAS u32x4*)(T_(1) + t128(d, 4 * q4 + g)); const int s0 = 32 * q4 + 8 * g;
#pragma unroll
            for (int i = 0; i < 4; ++i) s += bflo(w[i]) * wgv[s0 + 2 * i] + bfhi(w[i]) * wgv[s0 + 2 * i + 1]; }
        s += __shfl_xor(s, 1); s += __shfl_xor(s, 2);
        if (q4 == 0) ((float*)(p.ws + WS_NLOC))[item * 128 + d] = s; }
    __syncthreads();
}

__device__ void sample_item(const Params& p, lds_u8* L, int it) {
    const int tid = threadIdx.x, wid = tid >> 6, lane = tid & 63; const int bs = it >> 2, h = it & 3, row = TP + bs;
    const bf16_t* P = (const bf16_t*)(p.ws + WS_PROJ) + (size_t)row * NP; const float* G = (const float*)(p.ws + WS_GATES) + (size_t)row * 8;
    bf16_t* MIX = (bf16_t*)(p.ws + WS_MIX) + (size_t)row * D;
    LAS float* hb = SMF; LAS float* vsh = SMF + 128;
    const float ig = G[h], lf = logsig(G[4 + h]), m0 = p.in[6][bs * 4 + h];
    const float inter = lf + m0, mt = fmaxf(inter, ig), wi = fexp(ig - mt), wd = fexp(inter - mt);
    const int d4 = (lane & 31) * 4;
    float q4[4], k4[4];
    { const u32x2 qw = *(const u32x2*)(P + h * 128 + d4), kw = *(const u32x2*)(P + 512 + h * 128 + d4);
      q4[0] = bflo(qw.x); q4[1] = bfhi(qw.x); q4[2] = bflo(qw.y); q4[3] = bfhi(qw.y); k4[0] = bflo(kw.x); k4[1] = bfhi(kw.x); k4[2] = bflo(kw.y); k4[3] = bfhi(kw.y); }
    float qk = q4[0] * k4[0] + q4[1] * k4[1] + q4[2] * k4[2] + q4[3] * k4[3];
    for (int o = 16; o >= 1; o >>= 1) qk += __shfl_xor(qk, o);
    const f32x4 n0 = *(const f32x4*)(p.in[5] + (size_t)(bs * 4 + h) * 128 + d4);
    float nq = n0[0] * q4[0] + n0[1] * q4[1] + n0[2] * q4[2] + n0[3] * q4[3];
    for (int o = 16; o >= 1; o >>= 1) nq += __shfl_xor(nq, o);
    if (tid < 128) vsh[tid] = __uint_as_float(((unsigned)P[1024 + h * 128 + tid]) << 16);
    __syncthreads();
    const float s = qk * wi;
    const float* C0 = p.in[4] + (size_t)(bs * 4 + h) * 16384; float* C1 = p.out + O_CS + (size_t)(bs * 4 + h) * 16384;
#pragma unroll
    for (int i = 0; i < 8; ++i) { const int e = 16 * wid + 2 * i + (lane >> 5); const f32x4 cv = *(const f32x4*)(C0 + e * 128 + d4); const float ve = vsh[e];
        float cq = cv[0] * q4[0] + cv[1] * q4[1] + cv[2] * q4[2] + cv[3] * q4[3];
        for (int o = 16; o >= 1; o >>= 1) cq += __shfl_xor(cq, o);
        f32x4 cn; cn[0] = wd * cv[0] + wi * ve * k4[0]; cn[1] = wd * cv[1] + wi * ve * k4[1]; cn[2] = wd * cv[2] + wi * ve * k4[2]; cn[3] = wd * cv[3] + wi * ve * k4[3];
        *(f32x4*)(C1 + e * 128 + d4) = cn;
        if ((lane & 31) == 0) hb[e] = s * ve + wd * cq; }
    __syncthreads();
    if (wid == 0) {
        if (lane < 32) { f32x4 nn; nn[0] = wd * n0[0] + wi * k4[0]; nn[1] = wd * n0[1] + wi * k4[1]; nn[2] = wd * n0[2] + wi * k4[2]; nn[3] = wd * n0[3] + wi * k4[3];
            *(f32x4*)(p.out + O_NS + (size_t)(bs * 4 + h) * 128 + d4) = nn; }
        if (lane == 0) p.out[O_MS + bs * 4 + h] = mt;
        const float den = s + wd * nq, dn = fmaxf(fabsf(den), fexp(-mt)); const int e = 2 * lane;
        const float h0 = hb[e] / dn, h1 = hb[e + 1] / dn; const float ss = wsum(h0 * h0 + h1 * h1), rstd = 1.0f / sqrtf(ss * (1.0f / 128.0f) + 1e-6f);
        const unsigned ow = *(const unsigned*)(P + 1536 + h * 128 + e); const float* gh = p.in[12] + h * 128 + e;
        *(unsigned*)(MIX + h * 128 + e) = cvt_pk_bf16(h0 * rstd * gh[0] * bflo(ow), h1 * rstd * gh[1] * bfhi(ow));
    } else if (wid == 1) {
        const int e = 2 * lane; const unsigned vw = *(const unsigned*)(P + 2560 + h * 128 + e), uw = *(const unsigned*)(P + 2048 + h * 128 + e);
        const float x0 = bflo(vw), x1 = bfhi(vw); const float mean = wsum(x0 + x1) * (1.0f / 128.0f); const float d0 = x0 - mean, d1 = x1 - mean;
        const float var = wsum(d0 * d0 + d1 * d1) * (1.0f / 128.0f), rstd = 1.0f / sqrtf(var + 1e-6f);
        const float* lg = p.in[13] + h * 128 + e; const float* lb = p.in[14] + h * 128 + e;
        const float y0 = d0 * rstd * lg[0] + lb[0], y1 = d1 * rstd * lg[1] + lb[1];
        float* vo = p.out + O_VS + (size_t)(bs * 4 + h) * 128 + e; vo[0] = y0; vo[1] = y1;
        const float w00 = p.in[15][h * 16384], bs0 = p.in[16][h * 128];
        *(unsigned*)(MIX + 512 + h * 128 + e) = cvt_pk_bf16(bflo(uw) * (w00 * y0 + bs0), bfhi(uw) * (w00 * y1 + bs0));
    }
    __syncthreads();
}

__device__ void mlstm_scan(const Params& p) {
    const float* BC = (const float*)(p.ws + WS_BC); const float* PC = (const float*)(p.ws + WS_PC); const float* CL = (const float*)(p.ws + WS_H);
    bf16_t* CST = (bf16_t*)(p.ws + WS_ADA_CST); const float* NL = (const float*)(p.ws + WS_NLOC); float* NST = (float*)(p.ws + WS_NST); float* MST = (float*)(p.ws + WS_MST);
    for (int idx = blockIdx.x * 512 + threadIdx.x; idx < 32 * 4096; idx += gridDim.x * 512) {
        const int bh = idx >> 12, e4 = idx & 4095; float m = 0.f; f32x4 ca = {0.f, 0.f, 0.f, 0.f}, na = {0.f, 0.f, 0.f, 0.f};
        f32x4 cl[16], nl[16];
#pragma unroll
        for (int c = 0; c < 16; ++c) { cl[c] = __builtin_nontemporal_load((const f32x4*)(CL + (size_t)(bh * 16 + c) * 16384 + e4 * 4)); nl[c] = (f32x4){0.f, 0.f, 0.f, 0.f}; }
        if (e4 < 32) {
#pragma unroll
            for (int c = 0; c < 16; ++c) nl[c] = *(const f32x4*)(NL + (bh * 16 + c) * 128 + e4 * 4); }
#pragma unroll
        for (int c = 0; c < 16; ++c) { const int item = bh * 16 + c; const float P = PC[item], B = BC[item], mx = fmaxf(m, P), al = fexp(m - mx), be = fexp(P - mx);
            u32x2 w; w.x = cvt_pk_bf16(ca[0], ca[1]); w.y = cvt_pk_bf16(ca[2], ca[3]); *(u32x2*)(CST + (size_t)item * 16384 + e4 * 4) = w;
            ca = al * ca + be * cl[c];
            if (e4 < 32) { *(f32x4*)(NST + item * 128 + e4 * 4) = na; na = al * na + be * nl[c]; }
            if (e4 == 0) MST[item] = m;
            m = B + mx; }
        *(f32x4*)(p.out + O_CP + (size_t)bh * 16384 + e4 * 4) = ca;
        if (e4 < 32) *(f32x4*)(p.out + O_NP + bh * 128 + e4 * 4) = na;
        if (e4 == 0) p.out[O_MP + bh] = m;
    }
}

__device__ void cmlp_item(const Params& p, lds_u8* L, int item) {
    const int tid = threadIdx.x, wid = tid >> 6, lane = tid & 63, fr = lane & 15, fq = lane >> 4;
    const int h = item & 3, bc = item >> 2, row0 = bc * 128;
    const bf16_t* P = (const bf16_t*)(p.ws + WS_PROJ) + (size_t)row0 * NP; bf16_t* MIX = (bf16_t*)(p.ws + WS_MIX) + (size_t)row0 * D;
    LAS float* mean_s = SMF; LAS float* rstd_s = SMF + 128; LAS float* lg_s = SMF + 256; LAS float* lb_s = SMF + 384;
    { const int s = tid >> 2, q4 = tid & 3; float x[32]; float sm = 0.f;
#pragma unroll
        for (int g = 0; g < 4; ++g) { const u32x4 w = *(const u32x4*)(P + (size_t)s * NP + 2560 + h * 128 + 32 * q4 + 8 * g);
#pragma unroll
            for (int i = 0; i < 4; ++i) { x[8 * g + 2 * i] = bflo(w[i]); x[8 * g + 2 * i + 1] = bfhi(w[i]); sm += x[8 * g + 2 * i] + x[8 * g + 2 * i + 1]; } }
        sm += __shfl_xor(sm, 1); sm += __shfl_xor(sm, 2); const float mean = sm * (1.0f / 128.0f); float vq = 0.f;
#pragma unroll
        for (int i = 0; i < 32; ++i) { const float d = x[i] - mean; vq += d * d; }
        vq += __shfl_xor(vq, 1); vq += __shfl_xor(vq, 2);
        if (q4 == 0) { mean_s[s] = mean; rstd_s[s] = 1.0f / sqrtf(vq * (1.0f / 128.0f) + 1e-6f); }
        if (tid < 128) { lg_s[tid] = p.in[13][h * 128 + tid]; lb_s[tid] = p.in[14][h * 128 + tid]; } }
    { const float* W = p.in[15] + (size_t)h * 16384;
#pragma unroll
        for (int i = 0; i < 4; ++i) { const int g = tid + 512 * i, n = g >> 4, k8 = g & 15; const f32x4 a = *(const f32x4*)(W + n * 128 + 8 * k8), b = *(const f32x4*)(W + n * 128 + 8 * k8 + 4);
            float v[8] = {a[0], a[1], a[2], a[3], b[0], b[1], b[2], b[3]};
#pragma unroll
            for (int j = 0; j < 8; ++j) if (8 * k8 + j > n) v[j] = 0.f;
            u32x4 w; w.x = cvt_pk_bf16(v[0], v[1]); w.y = cvt_pk_bf16(v[2], v[3]); w.z = cvt_pk_bf16(v[4], v[5]); w.w = cvt_pk_bf16(v[6], v[7]);
            *(LAS u32x4*)(T_(0) + t128(n, k8)) = w; } }
    __syncthreads();
    stage_T(T_(2), P + 2560 + h * 128, NP, [&](int s, int e, float v) { return (v - mean_s[s]) * rstd_s[s] * lg_s[e] + lb_s[e]; });
    __syncthreads();
    f32x4 acc[8];
#pragma unroll
    for (int n = 0; n < 8; ++n) acc[n] = (f32x4){0.f, 0.f, 0.f, 0.f};
    mm16(acc, T_(0), 16 * wid, T_(2), fr, fq);
    const int t = 16 * wid + fr; const float bsv = p.in[16][h * 128 + t];
#pragma unroll
    for (int n = 0; n < 8; ++n) { const int e = 16 * n + 4 * fq; const u32x2 uw = *(const u32x2*)(P + (size_t)t * NP + 2048 + h * 128 + e);
        u32x2 o; o.x = cvt_pk_bf16(bflo(uw.x) * (acc[n][0] + bsv), bfhi(uw.x) * (acc[n][1] + bsv)); o.y = cvt_pk_bf16(bflo(uw.y) * (acc[n][2] + bsv), bfhi(uw.y) * (acc[n][3] + bsv));
        *(u32x2*)(MIX + (size_t)t * D + 512 + h * 128 + e) = o; }
    __syncthreads();
}

__device__ void mlstm_pass3(const Params& p, lds_u8* L, int item) {
    const int tid = threadIdx.x, wid = tid >> 6, lane = tid & 63, fr = lane & 15, fq = lane >> 4;
    const int bh = item >> 4, c = item & 15, b = bh >> 2, h = bh & 3, row0 = b * 2048 + c * 128;
    const bf16_t* P = (const bf16_t*)(p.ws + WS_PROJ) + (size_t)row0 * NP; bf16_t* MIX = (bf16_t*)(p.ws + WS_MIX) + (size_t)row0 * D;
    LAS float* bv = SMF; LAS float* av = SMF + 128; LAS float* pm = SMF + 256; LAS float* ns = SMF + 384;
    stage_nat(T_(0), P + h * 128, NP); stage_nat(T_(1), P + 512 + h * 128, NP);
    stage_T(T_(2), P + 1024 + h * 128, NP, [&](int, int, float v) { return v; });
    stage_nat(T_(3), (const bf16_t*)(p.ws + WS_ADA_CST) + (size_t)item * 16384, 128);
    if (tid < 128) { bv[tid] = ((const float*)(p.ws + WS_BV))[item * 128 + tid]; av[tid] = ((const float*)(p.ws + WS_AV))[item * 128 + tid];
        pm[tid] = ((const float*)(p.ws + WS_PM))[item * 128 + tid]; ns[tid] = ((const float*)(p.ws + WS_NST))[item * 128 + tid]; }
    const float mc = ((const float*)(p.ws + WS_MST))[item];
    __syncthreads();
    const int t = 16 * wid + fr;
    f32x4 acc[8], acc2[8];
#pragma unroll
    for (int n = 0; n < 8; ++n) acc[n] = (f32x4){0.f, 0.f, 0.f, 0.f};
    mm16(acc, T_(0), 16 * wid, T_(1), fr, fq);
    float qn = 0.f;
#pragma unroll
    for (int g = 0; g < 4; ++g) { const u32x4 w = *(const LAS u32x4*)(T_(0) + t128(t, 4 * g + fq)); const int d0 = 8 * (4 * g + fq);
#pragma unroll
        for (int i = 0; i < 4; ++i) qn += bflo(w[i]) * ns[d0 + 2 * i] + bfhi(w[i]) * ns[d0 + 2 * i + 1]; }
    qn += __shfl_xor(qn, 16); qn += __shfl_xor(qn, 32);
    const float Mt = fmaxf(mc, pm[t]); float rs = 0.f;
    __syncthreads();
#pragma unroll
    for (int n = 0; n < 8; ++n) { const int s0 = 16 * n + 4 * fq; f32x4 sp;
#pragma unroll
        for (int j = 0; j < 4; ++j) { const int s = s0 + j; sp[j] = (s <= t) ? acc[n][j] * fexp(av[s] - Mt) : 0.f; rs += sp[j]; }
        u32x2 o; o.x = cvt_pk_bf16(sp[0], sp[1]); o.y = cvt_pk_bf16(sp[2], sp[3]);
        *(LAS u32x2*)(T_(1) + t * 256 + ((((s0 >> 3)) ^ ((t ^ (t >> 3)) & 15)) << 4) + (s0 & 7) * 2) = o; }
    rs += __shfl_xor(rs, 16); rs += __shfl_xor(rs, 32);
    const float winter = fexp(mc - Mt), den = rs + winter * qn, mtt = bv[t] + Mt, dn = fmaxf(fabsf(den), fexp(-mtt)), rdn = 1.0f / dn;
#pragma unroll
    for (int n = 0; n < 8; ++n) acc2[n] = (f32x4){0.f, 0.f, 0.f, 0.f};
    mm16(acc2, T_(0), 16 * wid, T_(3), fr, fq);
#pragma unroll
    for (int n = 0; n < 8; ++n) acc2[n] *= winter;
    asm volatile("s_waitcnt lgkmcnt(0)" ::: "memory"); __builtin_amdgcn_wave_barrier();
    mm16(acc2, T_(1), 16 * wid, T_(2), fr, fq);
    float ss = 0.f;
#pragma unroll
    for (int n = 0; n < 8; ++n) { acc2[n] *= rdn; ss += acc2[n][0] * acc2[n][0] + acc2[n][1] * acc2[n][1] + acc2[n][2] * acc2[n][2] + acc2[n][3] * acc2[n][3]; }
    ss += __shfl_xor(ss, 16); ss += __shfl_xor(ss, 32);
    const float rstd = 1.0f / sqrtf(ss * (1.0f / 128.0f) + 1e-6f);
#pragma unroll
    for (int n = 0; n < 8; ++n) { const int e = 16 * n + 4 * fq; const u32x2 ow = *(const u32x2*)(P + (size_t)t * NP + 1536 + h * 128 + e); const f32x4 gh = *(const f32x4*)(p.in[12] + h * 128 + e);
        u32x2 o; o.x = cvt_pk_bf16(acc2[n][0] * rstd * gh[0] * bflo(ow.x), acc2[n][1] * rstd * gh[1] * bfhi(ow.x)); o.y = cvt_pk_bf16(acc2[n][2] * rstd * gh[2] * bflo(ow.y), acc2[n][3] * rstd * gh[3] * bfhi(ow.y));
        *(u32x2*)(MIX + (size_t)t * D + h * 128 + e) = o; }
    __syncthreads();
}
#ifndef MULTI_LAUNCH
#define MULTI_LAUNCH 0
#endif
#ifndef PHASE_MASK
#define PHASE_MASK 0xFFF
#endif
#ifndef REPEAT_MASK
#define REPEAT_MASK 0
#endif
#ifndef HOST_REPEAT_MASK
#define HOST_REPEAT_MASK 0
#endif
constexpr int N_PHASES = 12;
#ifndef PROBE_SPLIT
#define PROBE_SPLIT 0
#endif
#define XB_TMO      128
#define XB_XCNT(j)  (256  + 64 * (j))
#define XB_XSUB(j)  (1280 + 64 * (j))
#define XB_XGEN(j)  (2304 + 64 * (j))
#define XB_TOP      3328
#define XB_TOPGEN   3392
#define XCD_BAR_WORDS 3456
#define XB_SPIN_CAP (1u << 18)

__device__ __forceinline__ unsigned xb_ld(unsigned* p)              { return __hip_atomic_load(p, __ATOMIC_RELAXED, __HIP_MEMORY_SCOPE_AGENT); }
__device__ __forceinline__ unsigned xb_add(unsigned* p, unsigned v) { return __hip_atomic_fetch_add(p, v, __ATOMIC_RELAXED, __HIP_MEMORY_SCOPE_AGENT); }
__device__ __forceinline__ unsigned xb_xcc_id() { return (unsigned)__builtin_amdgcn_s_getreg((3 << 11) | 20) & 0xFu; }
#define XB_SPIN(cond, bar) do { unsigned _sp = 0; while (cond) { __builtin_amdgcn_s_sleep(1); \
    if ((++_sp & 255u) == 0u) { if (xb_ld(&(bar)[XB_TMO])) break; if (_sp > XB_SPIN_CAP) { atomicAdd(&(bar)[XB_TMO], 1u); break; } } } } while (0)

struct XcdBarrier {
    unsigned* bar; unsigned x;
    volatile LAS unsigned* st;
};
__device__ __forceinline__ XcdBarrier xcd_barrier_post(unsigned* bar, volatile LAS unsigned* st) {
    XcdBarrier b; b.bar = bar; b.x = xb_xcc_id(); b.st = st;
    if (threadIdx.x == 0) (void)xb_add(&bar[XB_XCNT(b.x)], 1u);
    return b;
}
__device__ __forceinline__ void xcd_barrier_complete(unsigned* bar, unsigned x, unsigned& nloc, unsigned& nx) {
    const unsigned G = gridDim.x * gridDim.y * gridDim.z;
    unsigned sum, cnt, mine, sp = 0u;
    for (;;) {
        sum = 0u; cnt = 0u; mine = 0u;
#pragma unroll
        for (unsigned j = 0; j < 16; ++j) { const unsigned c = xb_ld(&bar[XB_XCNT(j)]); sum += c; cnt += (c > 0u) ? 1u : 0u; mine = (j == x) ? c : mine; }
        if (sum == G) break;
        __builtin_amdgcn_s_sleep(1);
        if ((++sp & 255u) == 0u) { if (xb_ld(&bar[XB_TMO])) break; if (sp > XB_SPIN_CAP) { atomicAdd(&bar[XB_TMO], 1u); break; } }
    }
    nloc = mine > 0u ? mine : 1u; nx = cnt > 0u ? cnt : 1u;
}

__device__ __forceinline__ void xcd_barrier(const XcdBarrier& b) {
    asm volatile("s_waitcnt vmcnt(0)" ::: "memory");
    __syncthreads();
    if (threadIdx.x == 0) {
        unsigned* bar = b.bar;
        __builtin_amdgcn_s_waitcnt(0);
        unsigned nloc = b.st[0], nx = b.st[1];
        if (nloc == 0u) { xcd_barrier_complete(bar, b.x, nloc, nx); b.st[0] = nloc; b.st[1] = nx; }
        const unsigned old = xb_add(&bar[XB_XSUB(b.x)], 1u);
        const unsigned gen = old / nloc;
        if (old + 1u == (gen + 1u) * nloc) {
            __builtin_amdgcn_fence(__ATOMIC_RELEASE, "agent");
            asm volatile("s_waitcnt vmcnt(0)" ::: "memory");
            const unsigned og = xb_add(&bar[XB_TOP], 1u);
            const unsigned tg = og / nx;
            if (og + 1u == (tg + 1u) * nx) xb_add(&bar[XB_TOPGEN], 1u);
            else XB_SPIN(xb_ld(&bar[XB_TOPGEN]) == tg, bar);
            __builtin_amdgcn_fence(__ATOMIC_ACQUIRE, "agent");
            xb_add(&bar[XB_XGEN(b.x)], 1u);
            asm volatile("s_waitcnt vmcnt(0)" ::: "memory");
        } else {
            XB_SPIN(xb_ld(&bar[XB_XGEN(b.x)]) == gen, bar);
            __builtin_amdgcn_fence(__ATOMIC_ACQUIRE, "agent");
            asm volatile("s_waitcnt vmcnt(0)" ::: "memory");
        }
    }
    __syncthreads();
}


__global__ void __launch_bounds__(512, 2) mk_fwd(Params p) {
    extern __shared__ __attribute__((aligned(16))) unsigned char lds_raw[];
    lds_u8* L = (lds_u8*)lds_raw;
    cg::grid_group grid = cg::this_grid();
    const int G = gridDim.x, bx = blockIdx.x;
    unsigned char* ws = p.ws;
    bf16_t* WinT = (bf16_t*)(ws + WS_WIN); bf16_t* WoutT = (bf16_t*)(ws + WS_WOUT); bf16_t* WguT = (bf16_t*)(ws + WS_WGU); bf16_t* WdT = (bf16_t*)(ws + WS_WD);
    bf16_t* WadaT = (bf16_t*)(ws + WS_ADA_CST); bf16_t* SC = (bf16_t*)(ws + WS_SC); float* MOD = (float*)(ws + WS_MOD);
    bf16_t* H = (bf16_t*)(ws + WS_H); bf16_t* PROJ = (bf16_t*)(ws + WS_PROJ); bf16_t* ACT = (bf16_t*)(ws + WS_PROJ); bf16_t* MIX = (bf16_t*)(ws + WS_MIX);
    LAS f32x4* red = (LAS f32x4*)(L + 131072);
    if (threadIdx.x < 16) ((LAS unsigned*)(L + 131072 + 8192))[threadIdx.x] = 0u;
    __syncthreads();
    XcdBarrier xb; xb.bar = (unsigned*)(ws + WS_BAR + p.lo2); xb.x = 0; xb.st = nullptr;
    if (!MULTI_LAUNCH) xb = xcd_barrier_post((unsigned*)(ws + WS_BAR + p.lo2), (volatile LAS unsigned*)(L + 131072 + 8192));
    bool first = true;
#define IN(k) (((PHASE_MASK >> (k)) & 1) && p.ph_lo <= (k) && (k) < p.ph_hi)
#define PHASE(k) if (IN(k) && ((first ? (void)0 : (((k) == 1) ? grid.sync() : xcd_barrier(xb))), first = false, true))

    PHASE(0) { phase_convert(p, L); }
    PHASE(1) {
        for (int u = bx; u < 240; u += G) {
            if (u < 192) sgemm_unit<8, 1, true>(red, SC, WadaT, D, 0, 8, u * 32, u * 32 + 16, [&](int r, int c, f32x4 a, f32x4 a2) { const int col = u * 32 + c;
                *(f32x4*)(MOD + (size_t)r * NMOD + col) = a + *(const f32x4*)(p.in[8] + col); *(f32x4*)(MOD + (size_t)r * NMOD + col + 16) = a2 + *(const f32x4*)(p.in[8] + col + 16); });
            else { const int cb = (u - 192) * 128; auto f9 = [&](int r, int c, f32x4 a, f32x4) { if (r < 136) { const int col = cb + c; *(f32x4*)(MOD + (size_t)r * NMOD + col) = a + *(const f32x4*)(p.in[8] + col); } };
                sgemm_unit<1, 1, false, decltype(f9), true>(red, SC, WadaT, D, 8, 1, cb, 0, f9); } } }
    PHASE(2) { phase_norm<0>(p); }
    PHASE(3) {
        pg8::Gemm g{H, WinT, TP, NP, D}; pg8::StaticOrder S; S.init(TP, NP, G, bx); EpiProj E{PROJ};
        pg8::gemm_phase<EpiProj, pg8::StaticOrder>(L, g, S, E, nullptr);
        for (int u = bx; u < 192; u += G)
            sgemm_unit<8, 1, false>(red, H + (size_t)TP * D, WinT, D, 0, 8, u * 16, 0, [&](int r, int c, f32x4 a, f32x4) { E.small(TP + r, u * 16 + c, a); }); }
    PHASE(4) { for (int it = bx; it < 1024; it += G) { if (it < 512) mlstm_pass1(p, L, it); else sample_item(p, L, it - 512); } }
    PHASE(5) { mlstm_scan(p); for (int it = bx; it < 512; it += G) cmlp_item(p, L, it); }
    PHASE(6) { for (int it = bx; it < 512; it += G) mlstm_pass3(p, L, it); }
    PHASE(7) {
        pg8::Gemm g{MIX, WoutT, TP, D, D}; pg8::StaticOrder S; S.init(TP, D, G, bx); EpiRes E{p.in[0], MOD + 2048, p.out};
        pg8::gemm_phase<EpiRes, pg8::StaticOrder>(L, g, S, E, nullptr);
        for (int u = bx; u < 256; u += G) { const int ct = u >> 2, rg = u & 3;
            sgemm_unit<2, 4, false>(red, MIX + (size_t)TP * D, WoutT, D, rg * 2, 2, ct * 16, 0, [&](int r, int c, f32x4 a, f32x4) { const int col = ct * 16 + c;
                const f32x4 xv = *(const f32x4*)(p.in[1] + (size_t)r * D + col), gt = *(const f32x4*)(MOD + (size_t)(8 + r) * NMOD + 2048 + col); *(f32x4*)(p.out + (size_t)(TP + r) * D + col) = xv + gt * a; }); } }
    PHASE(8) { phase_norm<1>(p); }
    PHASE(9) {
        pg8::Gemm g{H, WguT, TP, 2 * DFF, D}; pg8::StaticOrder S; S.init(TP, 2 * DFF, G, bx); EpiSwi E{ACT};
        pg8::gemm_phase<EpiSwi, pg8::StaticOrder>(L, g, S, E, nullptr);
        for (int u = bx; u < 176; u += G) { const int br = (u >> 3) * 256 + (u & 7) * 16;
            sgemm_unit<8, 1, true>(red, H + (size_t)TP * D, WguT, D, 0, 8, br, br + 128, [&](int r, int c, f32x4 a, f32x4 b) { f32x4 v;
                for (int j = 0; j < 4; ++j) v[j] = a[j] * sigm(a[j]) * b[j];
                u32x2 w; w.x = cvt_pk_bf16(v[0], v[1]); w.y = cvt_pk_bf16(v[2], v[3]); *(u32x2*)(ACT + (size_t)(TP + r) * DFF + u * 16 + c) = w; }); } }
    PHASE(10) {
        pg8::Gemm g{ACT, WdT, TP, D, DFF}; pg8::StaticOrder S; S.init(TP, D, G, bx); EpiRes E{p.out, MOD + 5120, p.out};
        pg8::gemm_phase<EpiRes, pg8::StaticOrder>(L, g, S, E, nullptr);
        for (int u = bx; u < 256; u += G) { const int ct = u >> 2, rg = u & 3;
            sgemm_unit<2, 4, false>(red, ACT + (size_t)TP * DFF, WdT, DFF, rg * 2, 2, ct * 16, 0, [&](int r, int c, f32x4 a, f32x4) { const int col = ct * 16 + c;
                float* op = p.out + (size_t)(TP + r) * D + col; const f32x4 gt = *(const f32x4*)(MOD + (size_t)(8 + r) * NMOD + 5120 + col); *(f32x4*)op = *(const f32x4*)op + gt * a; }); } }
    PHASE(11) { phase_norm<2>(p); }
}

extern "C" void kernel_launch(void* const* d_in, const int* in_sizes, int n_in, void* d_out, int out_size, void* d_ws, size_t ws_size, hipStream_t stream) {
    static int grid = 0;
    if (grid == 0) {
        int dev = 0, cus = 0, per_cu = 0;
        (void)hipGetDevice(&dev); (void)hipDeviceGetAttribute(&cus, hipDeviceAttributeMultiprocessorCount, dev);
        if (hipFuncSetAttribute((const void*)mk_fwd, hipFuncAttributeMaxDynamicSharedMemorySize, LDS_BYTES) != hipSuccess) { fprintf(stderr, "kernel_launch: hipFuncSetAttribute failed\n"); grid = -1; return; }
        if (hipOccupancyMaxActiveBlocksPerMultiprocessor(&per_cu, (const void*)mk_fwd, 512, LDS_BYTES) != hipSuccess || per_cu < 1) { fprintf(stderr, "kernel_launch: occupancy query says %d\n", per_cu); per_cu = 1; }
        (void)hipGetLastError();
        grid = cus * per_cu;
        if (n_in != 22 || ws_size < WS_END) { fprintf(stderr, "kernel_launch: unexpected n_in %d / ws %zu\n", n_in, ws_size); grid = -1; return; }
    }
    if (grid < 0) return;
    Params p{};
    for (int i = 0; i < 22; ++i) p.in[i] = (const float*)d_in[i];
    p.out = (float*)d_out; p.ws = (unsigned char*)d_ws;
#if MULTI_LAUNCH
    p.lo2 = p.hi2 = 0; for (int ph = 0; ph < N_PHASES; ++ph) { p.ph_lo = ph; p.ph_hi = ph + 1; for (int r = 0; r < (((HOST_REPEAT_MASK >> ph) & 1) ? 2 : 1); ++r) hipLaunchKernelGGL(mk_fwd, dim3(grid), dim3(512), LDS_BYTES, stream, p); }
#else
    (void)hipMemsetAsync((unsigned char*)d_ws + WS_BAR, 0, 2 * 16384, stream);
    void* args[] = {&p};
#if PROBE_SPLIT
    p.ph_lo = 0; p.ph_hi = PROBE_HI1; p.lo2 = 0; p.hi2 = 0;
    hipError_t e = hipLaunchCooperativeKernel((const void*)mk_fwd, dim3(grid), dim3(512), args, LDS_BYTES, stream);
    p.ph_lo = PROBE_LO2; p.ph_hi = N_PHASES; p.lo2 = 16384;
    e = hipLaunchCooperativeKernel((const void*)mk_fwd, dim3(grid), dim3(512), args, LDS_BYTES, stream);
#else
    p.ph_lo = 0; p.ph_hi = N_PHASES; p.lo2 = 0; p.hi2 = 0;
    hipError_t e = hipLaunchCooperativeKernel((const void*)mk_fwd, dim3(grid), dim3(512), args, LDS_BYTES, stream);
#endif
    if (e != hipSuccess) fprintf(stderr, "kernel_launch: cooperative launch failed: %s (grid %d)\n", hipGetErrorString(e), grid);
#endif
}
```
